# Optimizing an MI355X kernel written in HIP

```python
import math
import jax, jax.numpy as jnp
from jax import lax
import numpy as np

D_MODEL = 1024
BATCH = 8
SEQ = 2048
DEPTH = 2

GRID_W = 64
CTX_LEN = 256
N_EVEN = (DEPTH + 1) // 2
N_ODD = DEPTH // 2
MIX_W = D_MODEL
EPS = 1e-6
DA_HEADS = 4
DA_V_DIM = (MIX_W // 2) // DA_HEADS
DA_QK_DIM = DA_V_DIM // 2
DA_QK_W = DA_HEADS * 2 * DA_QK_DIM
DA_V_W = DA_HEADS * DA_V_DIM
Q_BLOCK = 128
ROPE_THETA = 10000.0
POOL_WINDOWS = (2, 4, 8, 16)
POOL_W = MIX_W // 2
POOL_GDIM = POOL_W // len(POOL_WINDOWS)
EV_IN_W = 2 * DA_QK_W + DA_V_W + POOL_W
HG_HEAD_DIM = 128
HG_HEADS = MIX_W // HG_HEAD_DIM
HG_CHUNK = 64
HG_IN_W = 5 * MIX_W
D_FF = 2816
CONV_W = 3

kernel_name = "hybrid_diffattn_pool_hgrn2_dit_block"


def rmsnorm(x):
    x32 = x.astype(jnp.float32)
    y = x32 * lax.rsqrt(jnp.mean(x32 * x32, axis=-1, keepdims=True) + EPS)
    return y.astype(x.dtype)


def modulate(h, shift, scale):
    return h * (1.0 + scale) + shift


def axial_rope_tables(rows_n):
    row = jnp.repeat(jnp.arange(rows_n, dtype=jnp.float32), GRID_W)
    col = jnp.tile(jnp.arange(GRID_W, dtype=jnp.float32), rows_n)
    n_freq = DA_QK_DIM // 4
    inv = ROPE_THETA ** (-jnp.arange(n_freq, dtype=jnp.float32) / n_freq)
    ang = jnp.stack([row[:, None] * inv, col[:, None] * inv], axis=1)
    return jnp.cos(ang), jnp.sin(ang)


def apply_axial_rope(x, cos, sin):
    xr = x.reshape(x.shape[:-1] + (2, 2, DA_QK_DIM // 4))
    x1, x2 = xr[..., 0, :], xr[..., 1, :]
    c = cos[:, None, None].astype(x.dtype)
    s = sin[:, None, None].astype(x.dtype)
    out = jnp.stack([x1 * c - x2 * s, x2 * c + x1 * s], axis=-2)
    return out.reshape(x.shape)


def diff_attention(q, k, v, lam):
    B, Tq, H, M, dq = q.shape
    dv = v.shape[-1]
    nb = Tq // Q_BLOCK
    qb = q.reshape(B, nb, Q_BLOCK, H, M, dq).transpose(1, 0, 2, 3, 4, 5)
    scale = dq ** -0.5

    def one_block(qblk):
        s = jnp.einsum('bqhmd,bkhmd->bhmqk', qblk, k, preferred_element_type=jnp.float32) * scale
        p = jax.nn.softmax(s, axis=-1)
        a = p[:, :, 0] - lam * p[:, :, 1]
        return jnp.einsum('bhqk,bkhd->bqhd', a.astype(v.dtype), v)

    o = lax.map(one_block, qb)
    return o.transpose(1, 0, 2, 3, 4).reshape(B, Tq, H, dv)


def centred_mean_minus_self(u, w):
    B, T, C = u.shape
    cs = jnp.concatenate([jnp.zeros((B, 1, C), jnp.float32), jnp.cumsum(u.astype(jnp.float32), axis=1)], axis=1)
    t = jnp.arange(T)
    lo = jnp.clip(t - w // 2, 0, T)
    hi = jnp.clip(t + w - w // 2, 0, T)
    cnt = (hi - lo).astype(jnp.float32)
    mean = (cs[:, hi] - cs[:, lo]) / cnt[None, :, None]
    return mean.astype(u.dtype) - u


def pool_mixer(u, pool_w, pool_scale):
    B, T, _ = u.shape
    d = jnp.stack([centred_mean_minus_self(u[..., g * POOL_GDIM:(g + 1) * POOL_GDIM], w)
                   for g, w in enumerate(POOL_WINDOWS)], axis=2)
    y = jnp.einsum('btgc,gcd->btgd', d, pool_w).reshape(B, T, POOL_W)
    return y * pool_scale


def even_mixer(h_ctx, h_lat, w_in, w_out, lq1, lk1, lq2, lk2, subln, pool_w, pool_scale,
               lambda_init, cos, sin, need_ctx):
    def project(h):
        B, T, _ = h.shape
        p = h @ w_in
        q = p[..., :DA_QK_W].reshape(B, T, DA_HEADS, 2, DA_QK_DIM)
        k = p[..., DA_QK_W:2 * DA_QK_W].reshape(B, T, DA_HEADS, 2, DA_QK_DIM)
        v = p[..., 2 * DA_QK_W:2 * DA_QK_W + DA_V_W].reshape(B, T, DA_HEADS, DA_V_DIM)
        u = p[..., 2 * DA_QK_W + DA_V_W:]
        return q, k, v, u

    qc, kc, vc, uc = project(h_ctx)
    ql, kl, vl, ul = project(h_lat)
    ql = apply_axial_rope(ql, cos, sin)
    kl = apply_axial_rope(kl, cos, sin)
    lam = (jnp.exp(jnp.sum(lq1.astype(jnp.float32) * lk1.astype(jnp.float32)))
           - jnp.exp(jnp.sum(lq2.astype(jnp.float32) * lk2.astype(jnp.float32))) + lambda_init)
    gain = subln.reshape(DA_HEADS, DA_V_DIM) * (1.0 - lambda_init)

    def readout(o, u):
        B, T = o.shape[:2]
        o = (rmsnorm(o) * gain).reshape(B, T, DA_V_W)
        return jnp.concatenate([o, pool_mixer(u, pool_w, pool_scale)], axis=-1) @ w_out

    k_all = jnp.concatenate([kc, kl], axis=1)
    v_all = jnp.concatenate([vc, vl], axis=1)
    y_lat = readout(diff_attention(ql, k_all, v_all, lam), ul)
    y_ctx = readout(diff_attention(qc, kc, vc, lam), uc) if need_ctx else None
    return y_ctx, y_lat


def hgrn2_chunk_scan(q, logf, k, v, s0):
    B, T, H, dk = q.shape
    dv = v.shape[-1]
    n = T // HG_CHUNK

    def to_chunks(a):
        return a.reshape(B, n, HG_CHUNK, H, a.shape[-1]).transpose(1, 0, 3, 2, 4)

    mask = jnp.tril(jnp.ones((HG_CHUNK, HG_CHUNK), dtype=bool))[None, None, :, :, None]

    def step(S, xs):
        qc, gc, kc, vc = xs
        b = jnp.cumsum(gc, axis=2)
        diff = b[:, :, :, None, :] - b[:, :, None, :, :]
        decay = jnp.exp(jnp.where(mask, diff, -jnp.inf))
        A = jnp.einsum('bhtc,bhtsc,bhsc->bhts', qc, decay, kc)
        o = jnp.einsum('bhts,bhsd->bhtd', A, vc) + jnp.einsum('bhtc,bhcd->bhtd', qc * jnp.exp(b), S)
        b_last = b[:, :, -1:, :]
        S_new = (jnp.exp(b_last[:, :, 0, :])[..., None] * S
                 + jnp.einsum('bhsc,bhsd->bhcd', kc * jnp.exp(b_last - b), vc))
        return S_new, o

    S_fin, o = lax.scan(step, s0, (to_chunks(q), to_chunks(logf), to_chunks(k), to_chunks(v)))
    o = o.transpose(1, 0, 3, 2, 4).reshape(B, T, H, dv)
    return o, S_fin


def hgrn2_direction(q, z, v, lb, s0, reverse):
    f = lb + (1.0 - lb) * jax.nn.sigmoid(z.astype(jnp.float32))
    k = 1.0 - f
    logf = jnp.log(f)
    xs = (q.astype(jnp.float32), logf, k, v.astype(jnp.float32))
    if reverse:
        xs = tuple(jnp.flip(a, axis=1) for a in xs)
    o, s = hgrn2_chunk_scan(xs[0], xs[1], xs[2], xs[3], s0)
    if reverse:
        o = jnp.flip(o, axis=1)
    return o.astype(v.dtype), s


def odd_mixer(h_ctx, h_lat, w_in, w_out, lb_f, lb_b, norm_g, need_ctx):
    def project(h):
        B, T, _ = h.shape
        p = (h @ w_in).reshape(B, T, 5, HG_HEADS, HG_HEAD_DIM)
        return jax.nn.silu(p[:, :, 0]), p[:, :, 1], p[:, :, 2], p[:, :, 3], p[:, :, 4]

    qc, vc, zfc, zbc, gc = project(h_ctx)
    ql, vl, zfl, zbl, gl = project(h_lat)
    lbf = lb_f.reshape(HG_HEADS, HG_HEAD_DIM)
    lbb = lb_b.reshape(HG_HEADS, HG_HEAD_DIM)
    B = h_lat.shape[0]
    s0 = jnp.zeros((B, HG_HEADS, HG_HEAD_DIM, HG_HEAD_DIM), jnp.float32)
    oc_f, s_f = hgrn2_direction(qc, zfc, vc, lbf, s0, False)
    oc_b, s_b = hgrn2_direction(qc, zbc, vc, lbb, s0, True)
    ol_f, _ = hgrn2_direction(ql, zfl, vl, lbf, s_f, False)
    ol_b, _ = hgrn2_direction(ql, zbl, vl, lbb, s_b, True)
    gain = norm_g.reshape(HG_HEADS, HG_HEAD_DIM)

    def readout(o, g):
        Bq, T = o.shape[:2]
        o = rmsnorm(o) * gain * jax.nn.silu(g)
        return o.reshape(Bq, T, MIX_W) @ w_out

    y_lat = readout(ol_f + ol_b, gl)
    y_ctx = readout(oc_f + oc_b, gc) if need_ctx else None
    return y_ctx, y_lat


def conv_ffn(h, w_up, conv_w, conv_b, w_down):
    u = h @ w_up
    up = jnp.pad(u, ((0, 0), (1, 1), (0, 0)))
    u = up[:, :-2] * conv_w[0] + up[:, 1:-1] * conv_w[1] + up[:, 2:] * conv_w[2] + conv_b
    a, gate = jnp.split(u, 2, axis=-1)
    return (a * jax.nn.silu(gate)) @ w_down


def setup_inputs(seed: int = 0) -> dict:
    key = jax.random.key(seed)
    ks = jax.random.split(key, 26)
    f32 = jnp.float32

    def nrm(k, shape, scale):
        return jax.random.normal(k, shape, f32) * scale

    D = D_MODEL
    return {
        "x": nrm(ks[0], (BATCH, SEQ, D), 1.0),
        "c": nrm(ks[1], (BATCH, D), 1.0),
        "ctx": nrm(ks[2], (BATCH, CTX_LEN, D), 1.0),
        "c_ctx": nrm(ks[3], (D,), 1.0),
        "w_mod": nrm(ks[4], (DEPTH, D, 6 * D), 0.5 * D ** -0.5),
        "b_mod": nrm(ks[5], (DEPTH, 6 * D), 0.02),
        "ev_w_in": nrm(ks[6], (N_EVEN, D, EV_IN_W), D ** -0.5),
        "ev_w_out": nrm(ks[7], (N_EVEN, DA_V_W + POOL_W, D), (DA_V_W + POOL_W) ** -0.5),
        "da_lq1": nrm(ks[8], (N_EVEN, DA_QK_DIM), 0.1),
        "da_lk1": nrm(ks[9], (N_EVEN, DA_QK_DIM), 0.1),
        "da_lq2": nrm(ks[10], (N_EVEN, DA_QK_DIM), 0.1),
        "da_lk2": nrm(ks[11], (N_EVEN, DA_QK_DIM), 0.1),
        "da_subln": 1.0 + nrm(ks[12], (N_EVEN, DA_V_W), 0.02),
        "pool_w": nrm(ks[13], (N_EVEN, len(POOL_WINDOWS), POOL_GDIM, POOL_GDIM), POOL_GDIM ** -0.5),
        "pool_scale": 1.0 + nrm(ks[14], (N_EVEN, POOL_W), 0.02),
        "hg_w_in": nrm(ks[15], (N_ODD, D, HG_IN_W), D ** -0.5),
        "hg_w_out": nrm(ks[16], (N_ODD, MIX_W, D), MIX_W ** -0.5),
        "hg_lb_logits": nrm(ks[17], (2, DEPTH, MIX_W), 0.5),
        "hg_norm": 1.0 + nrm(ks[18], (N_ODD, MIX_W), 0.02),
        "ffn_w_up": nrm(ks[19], (DEPTH, D, 2 * D_FF), D ** -0.5),
        "ffn_conv_w": nrm(ks[20], (DEPTH, CONV_W, 2 * D_FF), CONV_W ** -0.5),
        "ffn_conv_b": nrm(ks[21], (DEPTH, 2 * D_FF), 0.02),
        "ffn_w_down": nrm(ks[22], (DEPTH, D_FF, D), D_FF ** -0.5),
        "final_norm": 1.0 + nrm(ks[23], (D,), 0.02),
    }


def reference(x, c, ctx, c_ctx, w_mod, b_mod, ev_w_in, ev_w_out, da_lq1, da_lk1, da_lq2, da_lk2,
              da_subln, pool_w, pool_scale, hg_w_in, hg_w_out, hg_lb_logits, hg_norm,
              ffn_w_up, ffn_conv_w, ffn_conv_b, ffn_w_down, final_norm):
    B, T, D = x.shape
    ROWS = T // GRID_W
    cos, sin = axial_rope_tables(ROWS)
    lb_p = jax.nn.softmax(hg_lb_logits.astype(jnp.float32), axis=1)
    lb = jnp.cumsum(lb_p, axis=1)
    lb = lb - lb[:, :1]
    xc = ctx
    for i in range(DEPTH):
        need_ctx = i < DEPTH - 1
        m_lat = (jax.nn.silu(c) @ w_mod[i] + b_mod[i]).reshape(B, 6, 1, D)
        m_ctx = (jax.nn.silu(c_ctx) @ w_mod[i] + b_mod[i]).reshape(6, 1, 1, D)
        h_lat = modulate(rmsnorm(x), m_lat[:, 0], m_lat[:, 1])
        h_ctx = modulate(rmsnorm(xc), m_ctx[0], m_ctx[1])
        j = i // 2
        if i % 2 == 0:
            lambda_init = 0.8 - 0.6 * math.exp(-0.3 * i)
            y_ctx, y_lat = even_mixer(h_ctx, h_lat, ev_w_in[j], ev_w_out[j], da_lq1[j], da_lk1[j],
                                      da_lq2[j], da_lk2[j], da_subln[j], pool_w[j], pool_scale[j],
                                      lambda_init, cos, sin, need_ctx)
        else:
            y_ctx, y_lat = odd_mixer(h_ctx, h_lat, hg_w_in[j], hg_w_out[j], lb[0, i], lb[1, i],
                                     hg_norm[j], need_ctx)
        x = x + m_lat[:, 2] * y_lat
        x = x + m_lat[:, 5] * conv_ffn(modulate(rmsnorm(x), m_lat[:, 3], m_lat[:, 4]),
                                       ffn_w_up[i], ffn_conv_w[i], ffn_conv_b[i], ffn_w_down[i])
        if need_ctx:
            xc = xc + m_ctx[2] * y_ctx
            xc = xc + m_ctx[5] * conv_ffn(modulate(rmsnorm(xc), m_ctx[3], m_ctx[4]),
                                          ffn_w_up[i], ffn_conv_w[i], ffn_conv_b[i], ffn_w_down[i])
    return rmsnorm(x) * final_norm
```

```cpp
#include <hip/hip_runtime.h>
#include <cstdint>
#include <cstdio>

typedef unsigned short bf16_t;
typedef _Float16 f16_t;

namespace cfg {
constexpr int D = 1024, BATCH = 8, SEQ = 2048, CTXL = 256;
constexpr int LAT = BATCH * SEQ, CTXR = BATCH * CTXL, ROWS = LAT + CTXR;
constexpr int EVN = 2048, HGN = 5120, FF = 2816, FF2 = 5632;
constexpr float EPS = 1e-6f;
constexpr float QSCALE = 0.125f * 1.4426950408889634f;
constexpr size_t MiB = 1u << 20;
constexpr size_t OFF_CTL = 0;
constexpr size_t OFF_MODS = 1 * MiB;
constexpr size_t OFF_ROPE = 1 * MiB + 512 * 1024;
constexpr size_t OFF_MISC = OFF_ROPE + 8192;
constexpr size_t OFF_BUP = 2 * MiB;
constexpr size_t OFF_BIN1 = 2 * MiB + 512 * 1024;
constexpr size_t OFF_SSQ = 3 * MiB;
constexpr size_t OFF_WIN1 = 4 * MiB, OFF_WOUT1 = 14 * MiB, OFF_WUP1 = 16 * MiB, OFF_WDN1 = 27 * MiB;
constexpr size_t OFF_XC = 32 * MiB + 512 * 1024;
constexpr size_t OFF_A = 41 * MiB;
constexpr size_t OFF_WIN0 = 78 * MiB, OFF_WOUT0 = 82 * MiB, OFF_WUP0 = 84 * MiB, OFF_WDN0 = 95 * MiB;
constexpr size_t OFF_B = 100 * MiB + 512 * 1024;
constexpr size_t OFF_P0 = OFF_B;
constexpr size_t OFF_A1 = OFF_B + 72 * MiB;
constexpr size_t OFF_ON = OFF_A1 + 36 * MiB;
constexpr size_t OFF_G = OFF_B;
constexpr size_t OFF_UCH = OFF_B + 99 * MiB;
constexpr size_t OFF_Q1 = 78 * MiB, OFF_GG1 = 110 * MiB, OFF_V1 = 142 * MiB, OFF_LF1 = 178 * MiB, OFF_LB1 = 214 * MiB;
constexpr size_t OFF_OSUM = OFF_A;
constexpr size_t OFF_A3 = OFF_Q1;
constexpr size_t WS_END = 256 * MiB;
static_assert(OFF_ON + 36 * MiB <= WS_END && OFF_UCH + (size_t)4610 * 5632 * 2 <= WS_END && OFF_LB1 + 36 * MiB <= WS_END, "ws map");
}
using namespace cfg;

__device__ __forceinline__ float bf2f(bf16_t v) { return __uint_as_float((unsigned)v << 16); }
__device__ __forceinline__ bf16_t f2bf(float f) { unsigned u = __float_as_uint(f); return (bf16_t)((u + 0x7fffu + ((u >> 16) & 1u)) >> 16); }
__device__ __forceinline__ float silu_f(float x) { return x / (1.f + expf(-x)); }
__device__ __forceinline__ float wave_sum(float v) {
#pragma unroll
    for (int o = 1; o < 64; o <<= 1) v += __shfl_xor(v, o);
    return v;
}
__device__ __forceinline__ int mod_row(int row) { return row < LAT ? (row >> 11) : 8; }
__device__ __forceinline__ float rstd_of(const float* ssq, int row) { const float4 s = *(const float4*)(ssq + (size_t)row * 4); return rsqrtf(((s.x + s.y) + (s.z + s.w)) * (1.f / D) + EPS); }
__host__ __device__ __forceinline__ int up_orig_col(int np) { const int T = np >> 8, jj = np & 255; return jj < 128 ? T * 128 + jj : FF + T * 128 + (jj - 128); }

__global__ void __launch_bounds__(256) k_mods(const float* c, const float* c_ctx, const float* w_mod, const float* b_mod, float* mods) {
    __shared__ float s[9][1024];
    __shared__ float red[4][9][64];
    const int l = blockIdx.y, tid = threadIdx.x, kg = tid >> 6, cl = tid & 63, col = blockIdx.x * 64 + cl;
    for (int i = tid; i < 9 * 1024; i += 256) { const int r = i >> 10, k = i & 1023; s[r][k] = silu_f(r < 8 ? c[r * 1024 + k] : c_ctx[k]); }
    __syncthreads();
    float acc[9];
#pragma unroll
    for (int r = 0; r < 9; ++r) acc[r] = 0.f;
    const float* w = w_mod + (size_t)l * 1024 * 6144 + col;
    for (int k = kg * 256; k < kg * 256 + 256; ++k) { const float wv = w[(size_t)k * 6144];
#pragma unroll
        for (int r = 0; r < 9; ++r) acc[r] += s[r][k] * wv; }
#pragma unroll
    for (int r = 0; r < 9; ++r) red[kg][r][cl] = acc[r];
    __syncthreads();
    if (kg == 0) {
#pragma unroll
        for (int r = 0; r < 9; ++r) mods[((size_t)l * 9 + r) * 6144 + col] = b_mod[l * 6144 + col] + ((red[0][r][cl] + red[1][r][cl]) + (red[2][r][cl] + red[3][r][cl]));
    }
}
__global__ void __launch_bounds__(1024) k_small(const float* lq1, const float* lk1, const float* lq2, const float* lk2, const float* subln, const float* lb_logits, float* rope, float* misc) {
    const int tid = threadIdx.x;
    if (tid == 0) { float s1 = 0.f, s2 = 0.f; for (int i = 0; i < 64; ++i) { s1 += lq1[i] * lk1[i]; s2 += lq2[i] * lk2[i]; } misc[0] = expf(s1) - expf(s2) + 0.2f; }
    if (tid < 512) misc[64 + tid] = subln[tid] * 0.8f;
    for (int i = tid; i < 2048; i += 1024) { const int dir = i >> 10, ch = i & 1023; const float l0 = lb_logits[(dir * 2 + 0) * 1024 + ch], l1 = lb_logits[(dir * 2 + 1) * 1024 + ch];
        const float m = fmaxf(l0, l1), e0 = expf(l0 - m), e1 = expf(l1 - m); misc[1024 + i] = e1 / (e0 + e1); }
    { const int pos = tid >> 4, f = tid & 15; const float inv = powf(10000.0f, -(float)f / 16.0f); const float ang = (float)pos * inv; rope[tid] = cosf(ang); rope[1024 + tid] = sinf(ang); }
}
__global__ void __launch_bounds__(256) k_transpose(const float* W, bf16_t* Wt, int ldw, int K, int N, int ldt, int koff, int mode) {
    __shared__ float t[32][33];
    const int tx = threadIdx.x & 31, ty = threadIdx.x >> 5, k0 = blockIdx.y * 32, n0 = blockIdx.x * 32;
    for (int i = ty; i < 32; i += 8) t[i][tx] = W[(size_t)(k0 + i) * ldw + n0 + tx];
    __syncthreads();
    for (int i = ty; i < 32; i += 8) { const int n = n0 + i; int np = n;
        if (mode == 1) { const int ch = n < FF ? n : n - FF; np = (ch >> 7) * 256 + (ch & 127) + (n < FF ? 0 : 128); }
        Wt[(size_t)np * ldt + koff + k0 + tx] = f2bf(t[tx][i]); }
}
__global__ void __launch_bounds__(256) k_weff(const float* pool_w, const float* pool_scale, const float* w_out, bf16_t* Wt) {
    const int n = blockIdx.x * 256 + threadIdx.x, gc = blockIdx.y, g = gc >> 7;
    float acc = 0.f;
    for (int d = 0; d < 128; ++d) acc += pool_w[(size_t)gc * 128 + d] * pool_scale[g * 128 + d] * w_out[(size_t)(512 + g * 128 + d) * 1024 + n];
    Wt[(size_t)n * 1024 + 512 + gc] = f2bf(acc);
}
__global__ void __launch_bounds__(256) k_bias(const float* mods_l, const bf16_t* Wt, float* bias, int chunk, int N) {
    const int n = blockIdx.x * 4 + (threadIdx.x >> 6), lane = threadIdx.x & 63;
    if (n >= N) return;
    float acc[9];
#pragma unroll
    for (int r = 0; r < 9; ++r) acc[r] = 0.f;
    for (int k = lane; k < 1024; k += 64) { const float w = bf2f(Wt[(size_t)n * 1024 + k]);
#pragma unroll
        for (int r = 0; r < 9; ++r) acc[r] += mods_l[(size_t)r * 6144 + chunk * 1024 + k] * w; }
#pragma unroll
    for (int r = 0; r < 9; ++r) { const float s = wave_sum(acc[r]); if (lane == 0) bias[(size_t)r * N + n] = s; }
}
__global__ void __launch_bounds__(256) k_norm_mod(const float* x, const float* ctx, const float* mods0, bf16_t* H) {
    const int row = blockIdx.x * 4 + (threadIdx.x >> 6), lane = threadIdx.x & 63;
    const float* xr = row < LAT ? x + (size_t)row * D : ctx + (size_t)(row - LAT) * D;
    const float* m = mods0 + (size_t)mod_row(row) * 6144;
    float4 v[4]; float s = 0.f;
#pragma unroll
    for (int j = 0; j < 4; ++j) { v[j] = *(const float4*)(xr + j * 256 + lane * 4); s += (v[j].x * v[j].x + v[j].y * v[j].y) + (v[j].z * v[j].z + v[j].w * v[j].w); }
    const float rstd = rsqrtf(wave_sum(s) * (1.f / D) + EPS);
#pragma unroll
    for (int j = 0; j < 4; ++j) { const int c0 = j * 256 + lane * 4; const float4 sh = *(const float4*)(m + c0), sc = *(const float4*)(m + 1024 + c0);
        ushort4 o; o.x = f2bf(v[j].x * rstd * (1.f + sc.x) + sh.x); o.y = f2bf(v[j].y * rstd * (1.f + sc.y) + sh.y); o.z = f2bf(v[j].z * rstd * (1.f + sc.z) + sh.z); o.w = f2bf(v[j].w * rstd * (1.f + sc.w) + sh.w);
        *(ushort4*)(H + (size_t)row * D + c0) = o; }
}
__global__ void __launch_bounds__(256) k_rowssq(const float* xlat, const float* xctx, float* ssq, int nrows, int pad_) {
    const int row = blockIdx.x * 4 + (threadIdx.x >> 6), lane = threadIdx.x & 63;
    if (row >= nrows) return;
    const float* xr = row < LAT ? xlat + (size_t)row * D : xctx + (size_t)(row - LAT) * D;
    float s = 0.f;
#pragma unroll
    for (int j = 0; j < 4; ++j) { const float4 v = *(const float4*)(xr + j * 256 + lane * 4); s += (v.x * v.x + v.y * v.y) + (v.z * v.z + v.w * v.w); }
    s = wave_sum(s);
    if (lane == 0) *(float4*)(ssq + (size_t)row * 4) = make_float4(s, 0.f, 0.f, 0.f);
}

template <class Epi>
__global__ void __launch_bounds__(256) k_gemm_naive(const bf16_t* A, const bf16_t* Bt, int K, int rowBeg, int rowEnd, int pad_, Epi epi) {
    __shared__ float As[16][65], Bs[16][65];
    const int tid = threadIdx.x, tx = tid & 15, ty = tid >> 4;
    const int r0 = rowBeg + blockIdx.y * 64, c0 = blockIdx.x * 64;
    float acc[4][4];
#pragma unroll
    for (int i = 0; i < 4; ++i)
#pragma unroll
        for (int j = 0; j < 4; ++j) acc[i][j] = 0.f;
    const int lr = tid >> 2, lk = (tid & 3) * 4;
    int arow = r0 + lr; if (arow > rowEnd - 1) arow = rowEnd - 1;
    const bf16_t* ap = A + (long)arow * K + lk;
    const bf16_t* bp = Bt + (size_t)(c0 + lr) * K + lk;
    for (int k0 = 0; k0 < K; k0 += 16) {
        const ushort4 av = *(const ushort4*)(ap + k0), bv = *(const ushort4*)(bp + k0);
        As[lk + 0][lr] = bf2f(av.x); As[lk + 1][lr] = bf2f(av.y); As[lk + 2][lr] = bf2f(av.z); As[lk + 3][lr] = bf2f(av.w);
        Bs[lk + 0][lr] = bf2f(bv.x); Bs[lk + 1][lr] = bf2f(bv.y); Bs[lk + 2][lr] = bf2f(bv.z); Bs[lk + 3][lr] = bf2f(bv.w);
        __syncthreads();
#pragma unroll
        for (int k = 0; k < 16; ++k) { float a[4], b[4];
#pragma unroll
            for (int i = 0; i < 4; ++i) { a[i] = As[k][ty * 4 + i]; b[i] = Bs[k][tx * 4 + i]; }
#pragma unroll
            for (int i = 0; i < 4; ++i)
#pragma unroll
                for (int j = 0; j < 4; ++j) acc[i][j] += a[i] * b[j]; }
        __syncthreads();
    }
#pragma unroll
    for (int i = 0; i < 4; ++i) { const int row = r0 + ty * 4 + i; if (row < rowEnd) {
#pragma unroll
        for (int j = 0; j < 4; ++j) epi(row, c0 + tx * 4 + j, acc[i][j]); } }
}
struct EpiStore { bf16_t* C; long long ldc; __device__ void operator()(int row, int col, float v) const { C[(size_t)row * ldc + col] = f2bf(v); } };
struct EpiUp { bf16_t* U; long long rowBase; const float* ssq; const float* bias;
    __device__ void operator()(int row, int col, float v) const { if (row < 0 || row >= ROWS) return; U[(size_t)(row - rowBase) * FF2 + col] = f2bf(rstd_of(ssq, row) * v + bias[(size_t)mod_row(row) * FF2 + col]); } };
struct EpiResid { const float* xin_lat; const float* xin_ctx; float* xout_lat; float* xout_ctx; const float* gate; const float* scale_next; bf16_t* An;
    __device__ void operator()(int row, int col, float v) const {
        const int r = mod_row(row); const size_t o = row < LAT ? (size_t)row * D + col : (size_t)(row - LAT) * D + col;
        const float xo = (row < LAT ? xin_lat : xin_ctx)[o]; const float xn = xo + gate[(size_t)r * 6144 + col] * v;
        (row < LAT ? xout_lat : xout_ctx)[o] = xn;
        if (An) An[(size_t)row * D + col] = f2bf(xn * (1.f + scale_next[(size_t)r * 6144 + col])); } };
struct EpiIn1 { const float* ssq; const float* bias; const float* lbv; bf16_t* Q; bf16_t* GG; bf16_t* V; f16_t* LF; f16_t* LB;
    __device__ void operator()(int row, int col, float acc) const {
        const int blk = col >> 10, ch = col & 1023; const float val = rstd_of(ssq, row) * acc + bias[(size_t)mod_row(row) * HGN + col];
        if (blk == 0) { if (row < LAT) Q[(size_t)row * D + ch] = f2bf(silu_f(val)); }
        else if (blk == 1) V[(size_t)row * D + ch] = f2bf(val);
        else if (blk == 4) { if (row < LAT) GG[(size_t)row * D + ch] = f2bf(silu_f(val)); }
        else { const float lb = lbv[(blk - 2) * 1024 + ch]; const float f = lb + (1.f - lb) / (1.f + expf(-val)); (blk == 2 ? LF : LB)[(size_t)row * D + ch] = (f16_t)logf(f); } } };

__global__ void __launch_bounds__(256) k_rope(bf16_t* P, const float* rope) {
    const int idx = blockIdx.x * 256 + threadIdx.x; const int row = idx >> 9, pi = idx & 511;
    const int col = (pi >> 4) * 32 + (pi & 15);
    const int axis = (col >> 5) & 1, f = col & 15;
    bf16_t* p = P + (size_t)row * EVN + col;
    float x1 = bf2f(p[0]), x2 = bf2f(p[16]);
    if (row < LAT) { const int t = row & 2047; const int pos = axis == 0 ? (t >> 6) : (t & 63); const float c = rope[pos * 16 + f], s = rope[1024 + pos * 16 + f];
        const float o1 = x1 * c - x2 * s, o2 = x2 * c + x1 * s; x1 = o1; x2 = o2; }
    if (col < 512) { x1 *= QSCALE; x2 *= QSCALE; }
    p[0] = f2bf(x1); p[16] = f2bf(x2);
}
__global__ void __launch_bounds__(64) k_attn_naive(const bf16_t* P, bf16_t* On) {
    const int qb = blockIdx.x, hm = blockIdx.y, h = hm >> 1, m = hm & 1; const int row = qb * 64 + threadIdx.x;
    const bool lat = (qb * 64) < LAT; const int b = lat ? (qb * 64) >> 11 : (qb * 64 - LAT) >> 8;
    float q[64]; { const bf16_t* qp = P + (size_t)row * EVN + h * 128 + m * 64;
#pragma unroll
        for (int d = 0; d < 64; ++d) q[d] = bf2f(qp[d]); }
    float o[128];
#pragma unroll
    for (int d = 0; d < 128; ++d) o[d] = 0.f;
    float mx = -1e30f, l = 0.f; const int nkeys = lat ? 2304 : 256;
    for (int j = 0; j < nkeys; ++j) {
        const int krow = j < 256 ? LAT + b * 256 + j : b * 2048 + (j - 256);
        const bf16_t* kp = P + (size_t)krow * EVN + 512 + h * 128 + m * 64; const bf16_t* vp = P + (size_t)krow * EVN + 1024 + h * 128;
        float s = 0.f;
#pragma unroll
        for (int d = 0; d < 64; ++d) s += q[d] * bf2f(kp[d]);
        const float mn = fmaxf(mx, s), alpha = exp2f(mx - mn), p = exp2f(s - mn); l = l * alpha + p; mx = mn;
#pragma unroll
        for (int d = 0; d < 128; ++d) o[d] = o[d] * alpha + p * bf2f(vp[d]);
    }
    const float il = 1.f / l; bf16_t* op = On + (((size_t)row * 4 + h) * 2 + m) * 128;
#pragma unroll
    for (int d = 0; d < 128; ++d) op[d] = f2bf(o[d] * il);
}
__global__ void __launch_bounds__(256) k_readout0(const bf16_t* On, const float* misc, bf16_t* A2) {
    const int w = blockIdx.x * 4 + (threadIdx.x >> 6), lane = threadIdx.x & 63; const int row = w >> 2, h = w & 3;
    const float lam = misc[0]; const bf16_t* p = On + ((size_t)row * 4 + h) * 256;
    const float a = bf2f(p[lane]) - lam * bf2f(p[128 + lane]), b = bf2f(p[64 + lane]) - lam * bf2f(p[192 + lane]);
    const float rstd = rsqrtf(wave_sum(a * a + b * b) * (1.f / 128.f) + EPS);
    A2[(size_t)row * D + h * 128 + lane] = f2bf(a * rstd * misc[64 + h * 128 + lane]);
    A2[(size_t)row * D + h * 128 + 64 + lane] = f2bf(b * rstd * misc[64 + h * 128 + 64 + lane]);
}
__global__ void __launch_bounds__(256) k_pool_d(const bf16_t* P, bf16_t* A2) {
    const int idx = blockIdx.x * 256 + threadIdx.x; const int row = idx >> 9, c = idx & 511, g = c >> 7, w = 2 << g;
    const int T = row < LAT ? 2048 : 256, t = row < LAT ? (row & 2047) : ((row - LAT) & 255), base = row - t;
    int lo = t - w / 2; if (lo < 0) lo = 0; int hi = t + w - w / 2; if (hi > T) hi = T;
    float s = 0.f; for (int tt = lo; tt < hi; ++tt) s += bf2f(P[(size_t)(base + tt) * EVN + 1536 + c]);
    A2[(size_t)row * D + 512 + c] = f2bf(s / (float)(hi - lo) - bf2f(P[(size_t)row * EVN + 1536 + c]));
}
__global__ void __launch_bounds__(256) k_convgate(const bf16_t* U, const float* cw, const float* cb, bf16_t* G, int rowBase, int rowBeg, int rowEnd, int pad_) {
    const long idx = (long)blockIdx.x * 256 + threadIdx.x; const int row = rowBeg + (int)(idx / FF), ch = (int)(idx % FF);
    if (row >= rowEnd) return;
    const int T = row < LAT ? 2048 : 256, t = row < LAT ? (row & 2047) : ((row - LAT) & 255);
    const int na = (ch >> 7) * 256 + (ch & 127), ng = na + 128;
    const bf16_t* u = U + (size_t)(row - rowBase) * FF2;
    float a = bf2f(u[na]) * cw[FF2 + ch] + cb[ch], gt = bf2f(u[ng]) * cw[FF2 + FF + ch] + cb[FF + ch];
    if (t > 0) { a += bf2f(u[na - FF2]) * cw[ch]; gt += bf2f(u[ng - FF2]) * cw[FF + ch]; }
    if (t < T - 1) { a += bf2f(u[na + FF2]) * cw[2 * FF2 + ch]; gt += bf2f(u[ng + FF2]) * cw[2 * FF2 + FF + ch]; }
    G[(size_t)row * FF + ch] = f2bf(a * silu_f(gt));
}
__global__ void __launch_bounds__(128) k_scan_naive(const bf16_t* Q, const bf16_t* V, const f16_t* LF, const f16_t* LB, bf16_t* OSUM, int dir, int pad_) {
    __shared__ float qs[128], fs[128], ks[128];
    const int b = blockIdx.x >> 3, h = blockIdx.x & 7, d = threadIdx.x;
    float S[128];
#pragma unroll
    for (int c = 0; c < 128; ++c) S[c] = 0.f;
    const f16_t* L = dir ? LB : LF;
    for (int step = 0; step < 2304; ++step) {
        const bool isctx = step < 256; const int t = isctx ? (dir ? 255 - step : step) : (dir ? 2047 - (step - 256) : (step - 256));
        const int row = isctx ? LAT + b * 256 + t : b * 2048 + t; const size_t o = (size_t)row * D + h * 128;
        const float f = expf((float)L[o + d]); fs[d] = f; ks[d] = 1.f - f; qs[d] = isctx ? 0.f : bf2f(Q[o + d]);
        const float v = bf2f(V[o + d]);
        __syncthreads();
        float acc = 0.f;
#pragma unroll
        for (int c = 0; c < 128; ++c) { S[c] = fs[c] * S[c] + ks[c] * v; acc += qs[c] * S[c]; }
        if (!isctx) { if (dir) acc += bf2f(OSUM[o + d]); OSUM[o + d] = f2bf(acc); }
        __syncthreads();
    }
}
__global__ void __launch_bounds__(256) k_combine1(const bf16_t* OSUM, const bf16_t* GG, const float* hg_norm, bf16_t* A3) {
    const int w = blockIdx.x * 4 + (threadIdx.x >> 6), lane = threadIdx.x & 63; const int row = w >> 3, h = w & 7;
    const size_t o = (size_t)row * D + h * 128;
    const float a = bf2f(OSUM[o + lane]), b = bf2f(OSUM[o + 64 + lane]);
    const float rstd = rsqrtf(wave_sum(a * a + b * b) * (1.f / 128.f) + EPS);
    A3[o + lane] = f2bf(a * rstd * hg_norm[h * 128 + lane] * bf2f(GG[o + lane]));
    A3[o + 64 + lane] = f2bf(b * rstd * hg_norm[h * 128 + 64 + lane] * bf2f(GG[o + 64 + lane]));
}
__global__ void __launch_bounds__(256) k_final(float* out, const float* fn) {
    const int row = blockIdx.x * 4 + (threadIdx.x >> 6), lane = threadIdx.x & 63; float* xr = out + (size_t)row * D;
    float4 v[4]; float s = 0.f;
#pragma unroll
    for (int j = 0; j < 4; ++j) { v[j] = *(const float4*)(xr + j * 256 + lane * 4); s += (v[j].x * v[j].x + v[j].y * v[j].y) + (v[j].z * v[j].z + v[j].w * v[j].w); }
    const float rstd = rsqrtf(wave_sum(s) * (1.f / D) + EPS);
#pragma unroll
    for (int j = 0; j < 4; ++j) { const float4 g = *(const float4*)(fn + j * 256 + lane * 4); *(float4*)(xr + j * 256 + lane * 4) = make_float4(v[j].x * rstd * g.x, v[j].y * rstd * g.y, v[j].z * rstd * g.z, v[j].w * rstd * g.w); }
}

template <class Epi> static void gemm_naive(hipStream_t st, const bf16_t* A, const bf16_t* Bt, int N, int K, int rowBeg, int rowEnd, Epi e) {
    dim3 g(N / 64, (rowEnd - rowBeg + 63) / 64); hipLaunchKernelGGL(k_gemm_naive<Epi>, g, dim3(256), 0, st, A, Bt, K, rowBeg, rowEnd, 0, e);
}
static void transpose(hipStream_t st, const float* W, int ldw, int K, int N, bf16_t* Wt, int ldt, int koff, int mode) {
    hipLaunchKernelGGL(k_transpose, dim3(N / 32, K / 32), dim3(256), 0, st, W, Wt, ldw, K, N, ldt, koff, mode);
}
static void ffn_naive(hipStream_t st, unsigned char* ws, int l, int nrows, const float* cw, const float* cb, const bf16_t* Wup, const bf16_t* Wdn, const float* mods, float* xlat, float* xc, const float* scale_next, bool want_next) {
    bf16_t* A0 = (bf16_t*)(ws + OFF_A); bf16_t* G = (bf16_t*)(ws + OFF_G); bf16_t* UCH = (bf16_t*)(ws + OFF_UCH); float* ssq = (float*)(ws + OFF_SSQ);
    const float* bup = (const float*)(ws + OFF_BUP) + (size_t)l * 9 * FF2;
    for (int c0 = 0; c0 < nrows; c0 += 4608) { int c1 = c0 + 4608; if (c1 > nrows) c1 = nrows; const int rb = c0 - 1, re = (c1 + 1 > ROWS) ? ROWS : c1 + 1;
        gemm_naive(st, A0, Wup, FF2, 1024, rb, re, EpiUp{UCH, rb, ssq, bup});
        const long n = (long)(c1 - c0) * FF; hipLaunchKernelGGL(k_convgate, dim3((unsigned)((n + 255) / 256)), dim3(256), 0, st, UCH, cw + (size_t)l * 3 * FF2, cb + (size_t)l * FF2, G, rb, c0, c1, 0); }
    gemm_naive(st, G, Wdn, 1024, FF, 0, nrows, EpiResid{xlat, xc, xlat, xc, mods + (size_t)l * 9 * 6144 + 5 * 1024, scale_next, want_next ? A0 : nullptr});
    if (want_next) hipLaunchKernelGGL(k_rowssq, dim3(nrows / 4), dim3(256), 0, st, xlat, xc, ssq, nrows, 0);
}

extern "C" void kernel_launch(void* const* d_in, const int* in_sizes, int n_in, void* d_out, int out_size, void* d_ws, size_t ws_size, hipStream_t st) {
    if (n_in != 24 || ws_size < WS_END || out_size != LAT * D) { fprintf(stderr, "kernel_launch: unexpected shapes (n_in %d, ws %zu, out %d)\n", n_in, ws_size, out_size); return; }
    const float* x = (const float*)d_in[0]; const float* c = (const float*)d_in[1]; const float* ctx = (const float*)d_in[2]; const float* c_ctx = (const float*)d_in[3];
    const float* w_mod = (const float*)d_in[4]; const float* b_mod = (const float*)d_in[5]; const float* ev_w_in = (const float*)d_in[6]; const float* ev_w_out = (const float*)d_in[7];
    const float* lq1 = (const float*)d_in[8]; const float* lk1 = (const float*)d_in[9]; const float* lq2 = (const float*)d_in[10]; const float* lk2 = (const float*)d_in[11];
    const float* subln = (const float*)d_in[12]; const float* pool_w = (const float*)d_in[13]; const float* pool_scale = (const float*)d_in[14];
    const float* hg_w_in = (const float*)d_in[15]; const float* hg_w_out = (const float*)d_in[16]; const float* lb_logits = (const float*)d_in[17]; const float* hg_norm = (const float*)d_in[18];
    const float* w_up = (const float*)d_in[19]; const float* conv_w = (const float*)d_in[20]; const float* conv_b = (const float*)d_in[21]; const float* w_down = (const float*)d_in[22]; const float* final_norm = (const float*)d_in[23];
    unsigned char* ws = (unsigned char*)d_ws; float* out = (float*)d_out;
    float* mods = (float*)(ws + OFF_MODS); float* rope = (float*)(ws + OFF_ROPE); float* misc = (float*)(ws + OFF_MISC); float* ssq = (float*)(ws + OFF_SSQ);
    float* bup = (float*)(ws + OFF_BUP); float* bin1 = (float*)(ws + OFF_BIN1); float* xc = (float*)(ws + OFF_XC);
    bf16_t *Win0 = (bf16_t*)(ws + OFF_WIN0), *Wout0 = (bf16_t*)(ws + OFF_WOUT0), *Wup0 = (bf16_t*)(ws + OFF_WUP0), *Wdn0 = (bf16_t*)(ws + OFF_WDN0);
    bf16_t *Win1 = (bf16_t*)(ws + OFF_WIN1), *Wout1 = (bf16_t*)(ws + OFF_WOUT1), *Wup1 = (bf16_t*)(ws + OFF_WUP1), *Wdn1 = (bf16_t*)(ws + OFF_WDN1);
    bf16_t *A0 = (bf16_t*)(ws + OFF_A), *A1 = (bf16_t*)(ws + OFF_A1), *P0 = (bf16_t*)(ws + OFF_P0), *ON = (bf16_t*)(ws + OFF_ON);
    bf16_t *Q1 = (bf16_t*)(ws + OFF_Q1), *GG1 = (bf16_t*)(ws + OFF_GG1), *V1 = (bf16_t*)(ws + OFF_V1), *OSUM = (bf16_t*)(ws + OFF_OSUM), *A3 = (bf16_t*)(ws + OFF_A3);
    f16_t *LF1 = (f16_t*)(ws + OFF_LF1), *LB1 = (f16_t*)(ws + OFF_LB1);

    hipLaunchKernelGGL(k_mods, dim3(96, 2), dim3(256), 0, st, c, c_ctx, w_mod, b_mod, mods);
    hipLaunchKernelGGL(k_small, dim3(1), dim3(1024), 0, st, lq1, lk1, lq2, lk2, subln, lb_logits, rope, misc);
    transpose(st, ev_w_in, EVN, 1024, EVN, Win0, 1024, 0, 0);
    transpose(st, ev_w_out, 1024, 512, 1024, Wout0, 1024, 0, 0);
    hipLaunchKernelGGL(k_weff, dim3(4, 512), dim3(256), 0, st, pool_w, pool_scale, ev_w_out, Wout0);
    transpose(st, w_up, FF2, 1024, FF2, Wup0, 1024, 0, 1);
    transpose(st, w_down, 1024, FF, 1024, Wdn0, FF, 0, 0);
    transpose(st, hg_w_in, HGN, 1024, HGN, Win1, 1024, 0, 0);
    transpose(st, hg_w_out, 1024, 1024, 1024, Wout1, 1024, 0, 0);
    transpose(st, w_up + (size_t)1024 * FF2, FF2, 1024, FF2, Wup1, 1024, 0, 1);
    transpose(st, w_down + (size_t)FF * 1024, 1024, FF, 1024, Wdn1, FF, 0, 0);
    hipLaunchKernelGGL(k_bias, dim3(FF2 / 4), dim3(256), 0, st, mods, Wup0, bup, 3, FF2);
    hipLaunchKernelGGL(k_bias, dim3(FF2 / 4), dim3(256), 0, st, mods + 9 * 6144, Wup1, bup + 9 * FF2, 3, FF2);
    hipLaunchKernelGGL(k_bias, dim3(HGN / 4), dim3(256), 0, st, mods + 9 * 6144, Win1, bin1, 0, HGN);
    hipLaunchKernelGGL(k_norm_mod, dim3(ROWS / 4), dim3(256), 0, st, x, ctx, mods, A0);
    gemm_naive(st, A0, Win0, EVN, 1024, 0, ROWS, EpiStore{P0, EVN});
    hipLaunchKernelGGL(k_rope, dim3(ROWS * 512 / 256), dim3(256), 0, st, P0, rope);
    hipLaunchKernelGGL(k_attn_naive, dim3(ROWS / 64, 8), dim3(64), 0, st, P0, ON);
    hipLaunchKernelGGL(k_readout0, dim3(ROWS), dim3(256), 0, st, ON, misc, A1);
    hipLaunchKernelGGL(k_pool_d, dim3(ROWS * 512 / 256), dim3(256), 0, st, P0, A1);
    gemm_naive(st, A1, Wout0, 1024, 1024, 0, ROWS, EpiResid{x, ctx, out, xc, mods + 2 * 1024, mods + 4 * 1024, A0});
    hipLaunchKernelGGL(k_rowssq, dim3(ROWS / 4), dim3(256), 0, st, out, xc, ssq, ROWS, 0);
    ffn_naive(st, ws, 0, ROWS, conv_w, conv_b, Wup0, Wdn0, mods, out, xc, mods + 9 * 6144 + 1 * 1024, true);
    gemm_naive(st, A0, Win1, HGN, 1024, 0, ROWS, EpiIn1{ssq, bin1, misc + 1024, Q1, GG1, V1, LF1, LB1});
    hipLaunchKernelGGL(k_scan_naive, dim3(64), dim3(128), 0, st, Q1, V1, LF1, LB1, OSUM, 0, 0);
    hipLaunchKernelGGL(k_scan_naive, dim3(64), dim3(128), 0, st, Q1, V1, LF1, LB1, OSUM, 1, 0);
    hipLaunchKernelGGL(k_combine1, dim3(LAT * 8 / 4), dim3(256), 0, st, OSUM, GG1, hg_norm, A3);
    gemm_naive(st, A3, Wout1, 1024, 1024, 0, LAT, EpiResid{out, xc, out, xc, mods + 9 * 6144 + 2 * 1024, mods + 9 * 6144 + 4 * 1024, A0});
    hipLaunchKernelGGL(k_rowssq, dim3(LAT / 4), dim3(256), 0, st, out, xc, ssq, LAT, 0);
    ffn_naive(st, ws, 1, LAT, conv_w, conv_b, Wup1, Wdn1, mods, out, xc, nullptr, false);
    hipLaunchKernelGGL(k_final, dim3(LAT / 4), dim3(256), 0, st, out, final_norm);
}
```

```cpp
#include <hip/hip_runtime.h>
#include <cstdint>
#include <cstdio>

typedef unsigned short bf16_t;
typedef _Float16 f16_t;

namespace cfg {
constexpr int D = 1024, BATCH = 8, SEQ = 2048, CTXL = 256;
constexpr int LAT = BATCH * SEQ, CTXR = BATCH * CTXL, ROWS = LAT + CTXR;
constexpr int EVN = 2048, HGN = 5120, FF = 2816, FF2 = 5632;
constexpr float EPS = 1e-6f;
constexpr float QSCALE = 0.125f * 1.4426950408889634f;
constexpr size_t MiB = 1u << 20;
constexpr size_t OFF_CTL = 0, CTL_ZERO_BYTES = 64 * 1024;
constexpr size_t OFF_MODS = 1 * MiB;
constexpr size_t OFF_ROPE = 1 * MiB + 512 * 1024;
constexpr size_t OFF_MISC = OFF_ROPE + 8192;
constexpr size_t OFF_BUP = 2 * MiB;
constexpr size_t OFF_BIN1 = 2 * MiB + 512 * 1024;
constexpr size_t OFF_SSQ = 3 * MiB;
constexpr size_t OFF_WIN1 = 4 * MiB, OFF_WOUT1 = 14 * MiB, OFF_WUP1 = 16 * MiB, OFF_WDN1 = 27 * MiB;
constexpr size_t OFF_XC = 32 * MiB + 512 * 1024;
constexpr size_t OFF_A = 41 * MiB;
constexpr size_t OFF_WIN0 = 78 * MiB, OFF_WOUT0 = 82 * MiB, OFF_WUP0 = 84 * MiB, OFF_WDN0 = 95 * MiB;
constexpr size_t OFF_B = 100 * MiB + 512 * 1024;
constexpr size_t OFF_P0 = OFF_B;
constexpr size_t OFF_A1 = OFF_B + 72 * MiB;
constexpr size_t OFF_ON = OFF_A1 + 36 * MiB;
constexpr size_t OFF_G = OFF_B;
constexpr size_t OFF_UCH = OFF_B + 99 * MiB;
constexpr size_t OFF_Q1 = 78 * MiB, OFF_GG1 = 110 * MiB, OFF_V1 = 142 * MiB, OFF_LF1 = 178 * MiB, OFF_LB1 = 214 * MiB;
constexpr size_t OFF_OSUM = OFF_A;
constexpr size_t OFF_A3 = OFF_Q1;
constexpr size_t WS_END = 256 * MiB;
static_assert(OFF_ON + 36 * MiB <= WS_END && OFF_UCH + (size_t)4610 * 5632 * 2 <= WS_END && OFF_LB1 + 36 * MiB <= WS_END, "ws map");
constexpr int NTHR = 512, LDS_BYTES = 147456;
constexpr int LDS_MISC = 140 * 1024;
}
using namespace cfg;

#define GAS __attribute__((address_space(1)))
#define LAS __attribute__((address_space(3)))
__device__ __forceinline__ float bf2f(bf16_t v) { return __uint_as_float((unsigned)v << 16); }
__device__ __forceinline__ bf16_t f2bf(float f) { unsigned u = __float_as_uint(f); return (bf16_t)((u + 0x7fffu + ((u >> 16) & 1u)) >> 16); }
__device__ __forceinline__ unsigned pk2(float lo, float hi) { return (unsigned)f2bf(lo) | ((unsigned)f2bf(hi) << 16); }
__device__ __forceinline__ float silu_f(float x) { return x / (1.f + expf(-x)); }
__device__ __forceinline__ float wave_sum(float v) {
#pragma unroll
    for (int o = 1; o < 64; o <<= 1) v += __shfl_xor(v, o);
    return v;
}
__device__ __forceinline__ int mod_row(int row) { return row < LAT ? (row >> 11) : 8; }
__device__ __forceinline__ float rstd_of(const float* ssq, int row) { const float4 s = *(const float4*)(ssq + (size_t)row * 4); return rsqrtf(((s.x + s.y) + (s.z + s.w)) * (1.f / D) + EPS); }

#define XB_TMO      128
#define XB_XCNT(j)  (256  + 64 * (j))
#define XB_XSUB(j)  (1280 + 64 * (j))
#define XB_XGEN(j)  (2304 + 64 * (j))
#define XB_TOP      3328
#define XB_TOPGEN   3392
#define XCD_BAR_WORDS 3456
#define XB_SPIN_CAP (1u << 18)
__device__ __forceinline__ unsigned xb_ld(unsigned* p)              { return __hip_atomic_load(p, __ATOMIC_RELAXED, __HIP_MEMORY_SCOPE_AGENT); }
__device__ __forceinline__ unsigned xb_add(unsigned* p, unsigned v) { return __hip_atomic_fetch_add(p, v, __ATOMIC_RELAXED, __HIP_MEMORY_SCOPE_AGENT); }
__device__ __forceinline__ unsigned xb_xcc_id() { return (unsigned)__builtin_amdgcn_s_getreg((3 << 11) | 20) & 0xFu; }
#define XB_SPIN(cond, bar) do { unsigned _sp = 0; while (cond) { __builtin_amdgcn_s_sleep(1); \
    if ((++_sp & 255u) == 0u) { if (xb_ld(&(bar)[XB_TMO])) break; if (_sp > XB_SPIN_CAP) { atomicAdd(&(bar)[XB_TMO], 1u); break; } } } } while (0)
struct XcdBarrier { unsigned* bar; unsigned x; volatile LAS unsigned* st; };
__device__ __forceinline__ XcdBarrier xcd_barrier_post(unsigned* bar, volatile LAS unsigned* st) {
    XcdBarrier b; b.bar = bar; b.x = xb_xcc_id(); b.st = st;
    if (threadIdx.x == 0) (void)xb_add(&bar[XB_XCNT(b.x)], 1u);
    return b;
}
__device__ __forceinline__ void xcd_barrier_complete(unsigned* bar, unsigned x, unsigned& nloc, unsigned& nx) {
    const unsigned G = gridDim.x * gridDim.y * gridDim.z;
    unsigned sum, cnt, mine, sp = 0u;
    for (;;) {
        sum = 0u; cnt = 0u; mine = 0u;
#pragma unroll
        for (unsigned j = 0; j < 16; ++j) { const unsigned c = xb_ld(&bar[XB_XCNT(j)]); sum += c; cnt += (c > 0u) ? 1u : 0u; mine = (j == x) ? c : mine; }
        if (sum == G) break;
        __builtin_amdgcn_s_sleep(1);
        if ((++sp & 255u) == 0u) { if (xb_ld(&bar[XB_TMO])) break; if (sp > XB_SPIN_CAP) { atomicAdd(&bar[XB_TMO], 1u); break; } }
    }
    nloc = mine > 0u ? mine : 1u; nx = cnt > 0u ? cnt : 1u;
}
__device__ __forceinline__ void xcd_barrier(const XcdBarrier& b) {
    asm volatile("s_waitcnt vmcnt(0)" ::: "memory");
    __syncthreads();
    if (threadIdx.x == 0) {
        unsigned* bar = b.bar;
        __builtin_amdgcn_s_waitcnt(0);
        unsigned nloc = b.st[0], nx = b.st[1];
        if (nloc == 0u) { xcd_barrier_complete(bar, b.x, nloc, nx); b.st[0] = nloc; b.st[1] = nx; }
        const unsigned old = xb_add(&bar[XB_XSUB(b.x)], 1u);
        const unsigned gen = old / nloc;
        if (old + 1u == (gen + 1u) * nloc) {
            __builtin_amdgcn_fence(__ATOMIC_RELEASE, "agent");
            asm volatile("s_waitcnt vmcnt(0)" ::: "memory");
            const unsigned og = xb_add(&bar[XB_TOP], 1u);
            const unsigned tg = og / nx;
            if (og + 1u == (tg + 1u) * nx) xb_add(&bar[XB_TOPGEN], 1u);
            else XB_SPIN(xb_ld(&bar[XB_TOPGEN]) == tg, bar);
            __builtin_amdgcn_fence(__ATOMIC_ACQUIRE, "agent");
            xb_add(&bar[XB_XGEN(b.x)], 1u);
            asm volatile("s_waitcnt vmcnt(0)" ::: "memory");
        } else {
            XB_SPIN(xb_ld(&bar[XB_XGEN(b.x)]) == gen, bar);
            __builtin_amdgcn_fence(__ATOMIC_ACQUIRE, "agent");
            asm volatile("s_waitcnt vmcnt(0)" ::: "memory");
        }
    }
    __syncthreads();
}

struct Args { const float* in[24]; float* out; unsigned char* ws; int ph_lo, ph_hi; };
struct Frame {
    LAS unsigned char* lds; int tid, lane, wave, gw, NGW, gt, NGT;
    const float *x, *c, *ctx, *c_ctx, *w_mod, *b_mod, *ev_w_in, *ev_w_out, *lq1, *lk1, *lq2, *lk2, *subln, *pool_w, *pool_scale, *hg_w_in, *hg_w_out, *lb_logits, *hg_norm, *w_up, *conv_w, *conv_b, *w_down, *final_norm;
    float* out; unsigned char* ws;
    float *mods, *rope, *misc, *ssq, *bup, *bin1, *xc;
    bf16_t *Win0, *Wout0, *Wup0, *Wdn0, *Win1, *Wout1, *Wup1, *Wdn1, *A0, *A1, *P0, *ON, *G, *UCH, *Q1, *GG1, *V1, *OSUM, *A3;
    f16_t *LF1, *LB1;
};

__device__ __forceinline__ void ph_mods(Frame& F) {
    LAS float* s = (LAS float*)F.lds;
    LAS float* red = (LAS float*)(F.lds + 36864);
    if ((int)blockIdx.x >= 192) return;
    for (int i = F.tid; i < 9 * 1024; i += NTHR) { const int r = i >> 10, k = i & 1023; s[i] = silu_f(r < 8 ? F.c[r * 1024 + k] : F.c_ctx[k]); }
    __syncthreads();
    const int kg = F.tid >> 6, cl = F.tid & 63;
    for (int item = blockIdx.x; item < 192; item += gridDim.x) {
        const int l = item / 96, col = (item % 96) * 64 + cl;
        float acc[9];
#pragma unroll
        for (int r = 0; r < 9; ++r) acc[r] = 0.f;
        const float* w = F.w_mod + (size_t)l * 1024 * 6144 + col;
        for (int k = kg * 128; k < kg * 128 + 128; ++k) { const float wv = w[(size_t)k * 6144];
#pragma unroll
            for (int r = 0; r < 9; ++r) acc[r] += s[r * 1024 + k] * wv; }
#pragma unroll
        for (int r = 0; r < 9; ++r) red[(kg * 9 + r) * 64 + cl] = acc[r];
        __syncthreads();
        if (kg == 0) {
#pragma unroll
            for (int r = 0; r < 9; ++r) { float t = 0.f;
#pragma unroll
                for (int g = 0; g < 8; ++g) t += red[(g * 9 + r) * 64 + cl];
                F.mods[((size_t)l * 9 + r) * 6144 + col] = F.b_mod[l * 6144 + col] + t; }
        }
        __syncthreads();
    }
}
__device__ __forceinline__ void ph_small(Frame& F) {
    if (blockIdx.x != gridDim.x - 1) return;
    const int tid = F.tid;
    if (tid == 0) { float s1 = 0.f, s2 = 0.f; for (int i = 0; i < 64; ++i) { s1 += F.lq1[i] * F.lk1[i]; s2 += F.lq2[i] * F.lk2[i]; } F.misc[0] = expf(s1) - expf(s2) + 0.2f; }
    F.misc[64 + tid] = F.subln[tid] * 0.8f;
    for (int i = tid; i < 2048; i += NTHR) { const int dir = i >> 10, ch = i & 1023; const float l0 = F.lb_logits[(dir * 2 + 0) * 1024 + ch], l1 = F.lb_logits[(dir * 2 + 1) * 1024 + ch];
        const float m = fmaxf(l0, l1), e0 = expf(l0 - m), e1 = expf(l1 - m); F.misc[1024 + i] = e1 / (e0 + e1); }
    for (int i = tid; i < 1024; i += NTHR) { const int pos = i >> 4, f = i & 15; const float inv = powf(10000.0f, -(float)f / 16.0f); const float ang = (float)pos * inv; F.rope[i] = cosf(ang); F.rope[1024 + i] = sinf(ang); }
}
__device__ __forceinline__ void transpose_item(const float* W, int K, int N, bf16_t* WT, int ldt, int mode, LAS float* scr, int item, int lane) {
    const int nblk = N / 32, kb = item / nblk, nb = item % nblk, k0 = 64 * kb, n0 = 32 * nb;
#pragma unroll 8
    for (int i = 0; i < 32; ++i) { const int kk = 2 * i + (lane >> 5); scr[kk * 33 + (lane & 31)] = W[(size_t)(k0 + kk) * N + n0 + (lane & 31)]; }
    asm volatile("s_waitcnt lgkmcnt(0)" ::: "memory");
    const int c = lane & 7;
#pragma unroll
    for (int j = 0; j < 4; ++j) { const int nn = (lane >> 3) + 8 * j; const LAS float* s = scr + (8 * c) * 33 + nn;
        uint4 o; o.x = pk2(s[0 * 33], s[1 * 33]); o.y = pk2(s[2 * 33], s[3 * 33]); o.z = pk2(s[4 * 33], s[5 * 33]); o.w = pk2(s[6 * 33], s[7 * 33]);
        const int n = n0 + nn; int np = n;
        if (mode == 1) { const int ch = n < FF ? n : n - FF; np = (ch >> 7) * 256 + (ch & 127) + (n < FF ? 0 : 128); }
        *(uint4*)(WT + (size_t)np * ldt + k0 + 8 * c) = o; }
    asm volatile("s_waitcnt lgkmcnt(0)" ::: "memory");
}
__device__ __forceinline__ void ph_transposes(Frame& F) {
    LAS float* scr = (LAS float*)(F.lds + 57344 + F.wave * 8448);
    constexpr int I0 = 16 * 64, I1 = 8 * 32, I2 = 16 * 176, I3 = 44 * 32, I4 = 16 * 160, I5 = 16 * 32, I6 = I2, I7 = I3;
    constexpr int NIT = I0 + I1 + I2 + I3 + I4 + I5 + I6 + I7;
    for (int it = F.gw; it < NIT; it += F.NGW) {
        int r = it;
        if (r < I0) { transpose_item(F.ev_w_in, 1024, EVN, F.Win0, 1024, 0, scr, r, F.lane); continue; } r -= I0;
        if (r < I1) { transpose_item(F.ev_w_out, 512, 1024, F.Wout0, 1024, 0, scr, r, F.lane); continue; } r -= I1;
        if (r < I2) { transpose_item(F.w_up, 1024, FF2, F.Wup0, 1024, 1, scr, r, F.lane); continue; } r -= I2;
        if (r < I3) { transpose_item(F.w_down, FF, 1024, F.Wdn0, FF, 0, scr, r, F.lane); continue; } r -= I3;
        if (r < I4) { transpose_item(F.hg_w_in, 1024, HGN, F.Win1, 1024, 0, scr, r, F.lane); continue; } r -= I4;
        if (r < I5) { transpose_item(F.hg_w_out, 1024, 1024, F.Wout1, 1024, 0, scr, r, F.lane); continue; } r -= I5;
        if (r < I6) { transpose_item(F.w_up + (size_t)1024 * FF2, 1024, FF2, F.Wup1, 1024, 1, scr, r, F.lane); continue; } r -= I6;
        transpose_item(F.w_down + (size_t)FF * 1024, FF, 1024, F.Wdn1, FF, 0, scr, r, F.lane);
    }
}
__device__ __forceinline__ void ph_weff(Frame& F) {
    for (int idx = F.gt; idx < 512 * 1024; idx += F.NGT) { const int gc = idx >> 10, n = idx & 1023, g = gc >> 7;
        float acc = 0.f;
        for (int d = 0; d < 128; ++d) acc += F.pool_w[(size_t)gc * 128 + d] * F.pool_scale[g * 128 + d] * F.ev_w_out[(size_t)(512 + g * 128 + d) * 1024 + n];
        F.Wout0[(size_t)n * 1024 + 512 + gc] = f2bf(acc); }
}
__device__ __forceinline__ void bias_item(const float* mods_l, int chunk, const bf16_t* Wt, int N, float* bias, int n, int lane) {
    float acc[9];
#pragma unroll
    for (int r = 0; r < 9; ++r) acc[r] = 0.f;
    for (int k = lane; k < 1024; k += 64) { const float w = bf2f(Wt[(size_t)n * 1024 + k]);
#pragma unroll
        for (int r = 0; r < 9; ++r) acc[r] += mods_l[(size_t)r * 6144 + chunk * 1024 + k] * w; }
#pragma unroll
    for (int r = 0; r < 9; ++r) { const float s = wave_sum(acc[r]); if (lane == 0) bias[(size_t)r * N + n] = s; }
}
__device__ __forceinline__ void ph_bias(Frame& F) {
    for (int it = F.gw; it < 2 * FF2 + HGN; it += F.NGW) {
        if (it < FF2) bias_item(F.mods, 3, F.Wup0, FF2, F.bup, it, F.lane);
        else if (it < 2 * FF2) bias_item(F.mods + 9 * 6144, 3, F.Wup1, FF2, F.bup + 9 * FF2, it - FF2, F.lane);
        else bias_item(F.mods + 9 * 6144, 0, F.Win1, HGN, F.bin1, it - 2 * FF2, F.lane);
    }
}
__device__ __forceinline__ void ph_norm_mod(Frame& F) {
    for (int row = F.gw; row < ROWS; row += F.NGW) {
        const float* xr = row < LAT ? F.x + (size_t)row * D : F.ctx + (size_t)(row - LAT) * D;
        const float* m = F.mods + (size_t)mod_row(row) * 6144;
        float4 v[4]; float s = 0.f;
#pragma unroll
        for (int j = 0; j < 4; ++j) { v[j] = *(const float4*)(xr + j * 256 + F.lane * 4); s += (v[j].x * v[j].x + v[j].y * v[j].y) + (v[j].z * v[j].z + v[j].w * v[j].w); }
        const float rstd = rsqrtf(wave_sum(s) * (1.f / D) + EPS);
#pragma unroll
        for (int j = 0; j < 4; ++j) { const int c0 = j * 256 + F.lane * 4; const float4 sh = *(const float4*)(m + c0), sc = *(const float4*)(m + 1024 + c0);
            uint2 o; o.x = pk2(v[j].x * rstd * (1.f + sc.x) + sh.x, v[j].y * rstd * (1.f + sc.y) + sh.y); o.y = pk2(v[j].z * rstd * (1.f + sc.z) + sh.z, v[j].w * rstd * (1.f + sc.w) + sh.w);
            *(uint2*)(F.A0 + (size_t)row * D + c0) = o; }
    }
}
__device__ __forceinline__ void ph_rowssq(Frame& F, int nrows) {
    for (int row = F.gw; row < nrows; row += F.NGW) {
        const float* xr = row < LAT ? F.out + (size_t)row * D : F.xc + (size_t)(row - LAT) * D;
        float s = 0.f;
#pragma unroll
        for (int j = 0; j < 4; ++j) { const float4 v = *(const float4*)(xr + j * 256 + F.lane * 4); s += (v.x * v.x + v.y * v.y) + (v.z * v.z + v.w * v.w); }
        s = wave_sum(s);
        if (F.lane == 0) *(float4*)(F.ssq + (size_t)row * 4) = make_float4(s, 0.f, 0.f, 0.f);
    }
}

template <class Epi>
__device__ __forceinline__ void gemm_naive_phase(Frame& F, const bf16_t* A, const bf16_t* Bt, int N, int K, int rowBeg, int rowEnd, const Epi& epi) {
    const int half = F.tid >> 8, tid = F.tid & 255, tx = tid & 15, ty = tid >> 4;
    LAS float* As = (LAS float*)(F.lds + half * 8320); LAS float* Bs = As + 16 * 65;
    const int tn = N / 64, tm = (rowEnd - rowBeg + 63) / 64, ntiles = tn * tm;
    const int lr = tid >> 2, lk = (tid & 3) * 4;
    for (int i = blockIdx.x; 2 * i < ntiles; i += gridDim.x) {
        const int tile = 2 * i + half, r0 = rowBeg + (tile / tn) * 64, c0 = (tile % tn) * 64;
        float acc[4][4];
#pragma unroll
        for (int a = 0; a < 4; ++a)
#pragma unroll
            for (int b = 0; b < 4; ++b) acc[a][b] = 0.f;
        int arow = r0 + lr; if (arow > rowEnd - 1) arow = rowEnd - 1;
        const bf16_t* ap = A + (long)arow * K + lk;
        const bf16_t* bp = Bt + (size_t)(c0 + lr) * K + lk;
        for (int k0 = 0; k0 < K; k0 += 16) {
            const ushort4 av = *(const ushort4*)(ap + k0), bv = *(const ushort4*)(bp + k0);
            As[(lk + 0) * 65 + lr] = bf2f(av.x); As[(lk + 1) * 65 + lr] = bf2f(av.y); As[(lk + 2) * 65 + lr] = bf2f(av.z); As[(lk + 3) * 65 + lr] = bf2f(av.w);
            Bs[(lk + 0) * 65 + lr] = bf2f(bv.x); Bs[(lk + 1) * 65 + lr] = bf2f(bv.y); Bs[(lk + 2) * 65 + lr] = bf2f(bv.z); Bs[(lk + 3) * 65 + lr] = bf2f(bv.w);
            __syncthreads();
#pragma unroll
            for (int k = 0; k < 16; ++k) { float a[4], b[4];
#pragma unroll
                for (int q = 0; q < 4; ++q) { a[q] = As[k * 65 + ty * 4 + q]; b[q] = Bs[k * 65 + tx * 4 + q]; }
#pragma unroll
                for (int q = 0; q < 4; ++q)
#pragma unroll
                    for (int j = 0; j < 4; ++j) acc[q][j] += a[q] * b[j]; }
            __syncthreads();
        }
#pragma unroll
        for (int q = 0; q < 4; ++q) { const int row = r0 + ty * 4 + q; if (row < rowEnd) {
#pragma unroll
            for (int j = 0; j < 4; ++j) epi(row, c0 + tx * 4 + j, acc[q][j]); } }
    }
}
struct EpiStore { bf16_t* C; long long ldc; __device__ void operator()(int row, int col, float v) const { C[(size_t)row * ldc + col] = f2bf(v); } };
struct EpiUp { bf16_t* U; long long rowBase; const float* ssq; const float* bias;
    __device__ void operator()(int row, int col, float v) const { if (row < 0 || row >= ROWS) return; U[(size_t)(row - rowBase) * FF2 + col] = f2bf(rstd_of(ssq, row) * v + bias[(size_t)mod_row(row) * FF2 + col]); } };
struct EpiResid { const float* xin_lat; const float* xin_ctx; float* xout_lat; float* xout_ctx; const float* gate; const float* scale_next; bf16_t* An;
    __device__ void operator()(int row, int col, float v) const {
        const int r = mod_row(row); const size_t o = row < LAT ? (size_t)row * D + col : (size_t)(row - LAT) * D + col;
        const float xo = (row < LAT ? xin_lat : xin_ctx)[o]; const float xn = xo + gate[(size_t)r * 6144 + col] * v;
        (row < LAT ? xout_lat : xout_ctx)[o] = xn;
        if (An) An[(size_t)row * D + col] = f2bf(xn * (1.f + scale_next[(size_t)r * 6144 + col])); } };
struct EpiIn1 { const float* ssq; const float* bias; const float* lbv; bf16_t* Q; bf16_t* GG; bf16_t* V; f16_t* LF; f16_t* LB;
    __device__ void operator()(int row, int col, float acc) const {
        const int blk = col >> 10, ch = col & 1023; const float val = rstd_of(ssq, row) * acc + bias[(size_t)mod_row(row) * HGN + col];
        if (blk == 0) { if (row < LAT) Q[(size_t)row * D + ch] = f2bf(silu_f(val)); }
        else if (blk == 1) V[(size_t)row * D + ch] = f2bf(val);
        else if (blk == 4) { if (row < LAT) GG[(size_t)row * D + ch] = f2bf(silu_f(val)); }
        else { const float lb = lbv[(blk - 2) * 1024 + ch]; const float f = lb + (1.f - lb) / (1.f + expf(-val)); (blk == 2 ? LF : LB)[(size_t)row * D + ch] = (f16_t)logf(f); } } };

__device__ __forceinline__ void ph_rope(Frame& F) {
    for (int idx = F.gt; idx < ROWS * 512; idx += F.NGT) { const int row = idx >> 9, pi = idx & 511;
        const int col = (pi >> 4) * 32 + (pi & 15); const int axis = (col >> 5) & 1, f = col & 15;
        bf16_t* p = F.P0 + (size_t)row * EVN + col;
        float x1 = bf2f(p[0]), x2 = bf2f(p[16]);
        if (row < LAT) { const int t = row & 2047; const int pos = axis == 0 ? (t >> 6) : (t & 63); const float c = F.rope[pos * 16 + f], s = F.rope[1024 + pos * 16 + f];
            const float o1 = x1 * c - x2 * s, o2 = x2 * c + x1 * s; x1 = o1; x2 = o2; }
        if (col < 512) { x1 *= QSCALE; x2 *= QSCALE; }
        p[0] = f2bf(x1); p[16] = f2bf(x2); }
}
__device__ __forceinline__ void ph_attn_naive(Frame& F) {
    const bf16_t* P = F.P0;
    for (int it = F.gw; it < (ROWS / 64) * 8; it += F.NGW) {
        const int qb = __builtin_amdgcn_readfirstlane(it >> 3), hm = __builtin_amdgcn_readfirstlane(it & 7), h = hm >> 1, m = hm & 1; const int row = qb * 64 + F.lane;
        const bool lat = (qb * 64) < LAT; const int b = lat ? (qb * 64) >> 11 : (qb * 64 - LAT) >> 8;
        float q[64]; { const bf16_t* qp = P + (size_t)row * EVN + h * 128 + m * 64;
#pragma unroll
            for (int d = 0; d < 64; ++d) q[d] = bf2f(qp[d]); }
        float o[128];
#pragma unroll
        for (int d = 0; d < 128; ++d) o[d] = 0.f;
        float mx = -1e30f, l = 0.f; const int nkeys = lat ? 2304 : 256;
        for (int j = 0; j < nkeys; ++j) {
            const int krow = j < 256 ? LAT + b * 256 + j : b * 2048 + (j - 256);
            const bf16_t* kp = P + (size_t)krow * EVN + 512 + h * 128 + m * 64; const bf16_t* vp = P + (size_t)krow * EVN + 1024 + h * 128;
            float s = 0.f;
#pragma unroll
            for (int d = 0; d < 64; ++d) s += q[d] * bf2f(kp[d]);
            const float mn = fmaxf(mx, s), alpha = exp2f(mx - mn), p = exp2f(s - mn); l = l * alpha + p; mx = mn;
#pragma unroll
            for (int d = 0; d < 128; ++d) o[d] = o[d] * alpha + p * bf2f(vp[d]);
        }
        const float il = 1.f / l; bf16_t* op = F.ON + (((size_t)row * 4 + h) * 2 + m) * 128;
#pragma unroll
        for (int d = 0; d < 128; ++d) op[d] = f2bf(o[d] * il);
    }
}
__device__ __forceinline__ void ph_readout0(Frame& F) {
    const float lam = F.misc[0];
    for (int w = F.gw; w < ROWS * 4; w += F.NGW) { const int row = w >> 2, h = w & 3, lane = F.lane;
        const bf16_t* p = F.ON + ((size_t)row * 4 + h) * 256;
        const float a = bf2f(p[lane]) - lam * bf2f(p[128 + lane]), b = bf2f(p[64 + lane]) - lam * bf2f(p[192 + lane]);
        const float rstd = rsqrtf(wave_sum(a * a + b * b) * (1.f / 128.f) + EPS);
        F.A1[(size_t)row * D + h * 128 + lane] = f2bf(a * rstd * F.misc[64 + h * 128 + lane]);
        F.A1[(size_t)row * D + h * 128 + 64 + lane] = f2bf(b * rstd * F.misc[64 + h * 128 + 64 + lane]); }
}
__device__ __forceinline__ void ph_pool_d(Frame& F) {
    const bf16_t* P = F.P0;
    for (int idx = F.gt; idx < ROWS * 512; idx += F.NGT) { const int row = idx >> 9, c = idx & 511, g = c >> 7, w = 2 << g;
        const int T = row < LAT ? 2048 : 256, t = row < LAT ? (row & 2047) : ((row - LAT) & 255), base = row - t;
        int lo = t - w / 2; if (lo < 0) lo = 0; int hi = t + w - w / 2; if (hi > T) hi = T;
        float s = 0.f; for (int tt = lo; tt < hi; ++tt) s += bf2f(P[(size_t)(base + tt) * EVN + 1536 + c]);
        F.A1[(size_t)row * D + 512 + c] = f2bf(s / (float)(hi - lo) - bf2f(P[(size_t)row * EVN + 1536 + c])); }
}
__device__ __forceinline__ void ph_convgate(Frame& F, int l, int rowBase, int rowBeg, int rowEnd) {
    const float* cw = F.conv_w + (size_t)l * 3 * FF2; const float* cb = F.conv_b + (size_t)l * FF2;
    const long n = (long)(rowEnd - rowBeg) * FF;
    for (long idx = F.gt; idx < n; idx += F.NGT) { const int row = rowBeg + (int)(idx / FF), ch = (int)(idx % FF);
        const int T = row < LAT ? 2048 : 256, t = row < LAT ? (row & 2047) : ((row - LAT) & 255);
        const int na = (ch >> 7) * 256 + (ch & 127), ng = na + 128;
        const bf16_t* u = F.UCH + (size_t)(row - rowBase) * FF2;
        float a = bf2f(u[na]) * cw[FF2 + ch] + cb[ch], gt = bf2f(u[ng]) * cw[FF2 + FF + ch] + cb[FF + ch];
        if (t > 0) { a += bf2f(u[na - FF2]) * cw[ch]; gt += bf2f(u[ng - FF2]) * cw[FF + ch]; }
        if (t < T - 1) { a += bf2f(u[na + FF2]) * cw[2 * FF2 + ch]; gt += bf2f(u[ng + FF2]) * cw[2 * FF2 + FF + ch]; }
        F.G[(size_t)row * FF + ch] = f2bf(a * silu_f(gt)); }
}
__device__ __forceinline__ void ph_scan_naive(Frame& F, int dir) {
    if ((int)blockIdx.x * 4 >= 64) return;
    const int vb = blockIdx.x * 4 + (F.tid >> 7), d = F.tid & 127;
    LAS float* qs = (LAS float*)(F.lds + (F.tid >> 7) * 1536); LAS float* fs = qs + 128; LAS float* ks = qs + 256;
    const int b = vb >> 3, h = vb & 7;
    float S[128];
#pragma unroll
    for (int c = 0; c < 128; ++c) S[c] = 0.f;
    const f16_t* L = dir ? F.LB1 : F.LF1;
    for (int step = 0; step < 2304; ++step) {
        const bool isctx = step < 256; const int t = isctx ? (dir ? 255 - step : step) : (dir ? 2047 - (step - 256) : (step - 256));
        const int row = isctx ? LAT + b * 256 + t : b * 2048 + t; const size_t o = (size_t)row * D + h * 128;
        const float f = expf((float)L[o + d]); fs[d] = f; ks[d] = 1.f - f; qs[d] = isctx ? 0.f : bf2f(F.Q1[o + d]);
        const float v = bf2f(F.V1[o + d]);
        __syncthreads();
        float acc = 0.f;
#pragma unroll
        for (int c = 0; c < 128; ++c) { S[c] = fs[c] * S[c] + ks[c] * v; acc += qs[c] * S[c]; }
        if (!isctx) { if (dir) acc += bf2f(F.OSUM[o + d]); F.OSUM[o + d] = f2bf(acc); }
        __syncthreads();
    }
}
__device__ __forceinline__ void ph_combine1(Frame& F) {
    for (int w = F.gw; w < LAT * 8; w += F.NGW) { const int row = w >> 3, h = w & 7, lane = F.lane; const size_t o = (size_t)row * D + h * 128;
        const float a = bf2f(F.OSUM[o + lane]), b = bf2f(F.OSUM[o + 64 + lane]);
        const float rstd = rsqrtf(wave_sum(a * a + b * b) * (1.f / 128.f) + EPS);
        F.A3[o + lane] = f2bf(a * rstd * F.hg_norm[h * 128 + lane] * bf2f(F.GG1[o + lane]));
        F.A3[o + 64 + lane] = f2bf(b * rstd * F.hg_norm[h * 128 + 64 + lane] * bf2f(F.GG1[o + 64 + lane])); }
}
__device__ __forceinline__ void ph_final(Frame& F) {
    for (int row = F.gw; row < LAT; row += F.NGW) { float* xr = F.out + (size_t)row * D;
        float4 v[4]; float s = 0.f;
#pragma unroll
        for (int j = 0; j < 4; ++j) { v[j] = *(const float4*)(xr + j * 256 + F.lane * 4); s += (v[j].x * v[j].x + v[j].y * v[j].y) + (v[j].z * v[j].z + v[j].w * v[j].w); }
        const float rstd = rsqrtf(wave_sum(s) * (1.f / D) + EPS);
#pragma unroll
        for (int j = 0; j < 4; ++j) { const float4 g = *(const float4*)(F.final_norm + j * 256 + F.lane * 4); *(float4*)(xr + j * 256 + F.lane * 4) = make_float4(v[j].x * rstd * g.x, v[j].y * rstd * g.y, v[j].z * rstd * g.z, v[j].w * rstd * g.w); }
    }
}

constexpr int NPHASE = 14;
__global__ void __launch_bounds__(NTHR, 2) mk_fwd(Args args) {
    extern __shared__ __attribute__((aligned(16))) unsigned char lds_raw[];
    Frame F;
    F.lds = (LAS unsigned char*)lds_raw;
    F.tid = threadIdx.x; F.lane = F.tid & 63; F.wave = __builtin_amdgcn_readfirstlane(F.tid >> 6);
    F.gw = blockIdx.x * 8 + F.wave; F.NGW = gridDim.x * 8; F.gt = blockIdx.x * NTHR + F.tid; F.NGT = gridDim.x * NTHR;
    F.x = args.in[0]; F.c = args.in[1]; F.ctx = args.in[2]; F.c_ctx = args.in[3]; F.w_mod = args.in[4]; F.b_mod = args.in[5]; F.ev_w_in = args.in[6]; F.ev_w_out = args.in[7];
    F.lq1 = args.in[8]; F.lk1 = args.in[9]; F.lq2 = args.in[10]; F.lk2 = args.in[11]; F.subln = args.in[12]; F.pool_w = args.in[13]; F.pool_scale = args.in[14];
    F.hg_w_in = args.in[15]; F.hg_w_out = args.in[16]; F.lb_logits = args.in[17]; F.hg_norm = args.in[18]; F.w_up = args.in[19]; F.conv_w = args.in[20]; F.conv_b = args.in[21]; F.w_down = args.in[22]; F.final_norm = args.in[23];
    F.out = args.out; unsigned char* ws = args.ws; F.ws = ws;
    F.mods = (float*)(ws + OFF_MODS); F.rope = (float*)(ws + OFF_ROPE); F.misc = (float*)(ws + OFF_MISC); F.ssq = (float*)(ws + OFF_SSQ);
    F.bup = (float*)(ws + OFF_BUP); F.bin1 = (float*)(ws + OFF_BIN1); F.xc = (float*)(ws + OFF_XC);
    F.Win0 = (bf16_t*)(ws + OFF_WIN0); F.Wout0 = (bf16_t*)(ws + OFF_WOUT0); F.Wup0 = (bf16_t*)(ws + OFF_WUP0); F.Wdn0 = (bf16_t*)(ws + OFF_WDN0);
    F.Win1 = (bf16_t*)(ws + OFF_WIN1); F.Wout1 = (bf16_t*)(ws + OFF_WOUT1); F.Wup1 = (bf16_t*)(ws + OFF_WUP1); F.Wdn1 = (bf16_t*)(ws + OFF_WDN1);
    F.A0 = (bf16_t*)(ws + OFF_A); F.A1 = (bf16_t*)(ws + OFF_A1); F.P0 = (bf16_t*)(ws + OFF_P0); F.ON = (bf16_t*)(ws + OFF_ON); F.G = (bf16_t*)(ws + OFF_G); F.UCH = (bf16_t*)(ws + OFF_UCH);
    F.Q1 = (bf16_t*)(ws + OFF_Q1); F.GG1 = (bf16_t*)(ws + OFF_GG1); F.V1 = (bf16_t*)(ws + OFF_V1); F.OSUM = (bf16_t*)(ws + OFF_OSUM); F.A3 = (bf16_t*)(ws + OFF_A3);
    F.LF1 = (f16_t*)(ws + OFF_LF1); F.LB1 = (f16_t*)(ws + OFF_LB1);

    volatile LAS unsigned* MISC = (volatile LAS unsigned*)(F.lds + LDS_MISC);
    if (F.tid < 64) MISC[F.tid] = 0u;
    __syncthreads();
    XcdBarrier bar = xcd_barrier_post((unsigned*)(ws + OFF_CTL) + 1024, MISC + 8);
#define GRID_BAR() xcd_barrier(bar)
    const int lo = args.ph_lo, hi = args.ph_hi;
#define IN(k) (lo <= (k) && (k) < hi)
#define SEAM(k) do { if (IN(k) && IN((k) + 1)) GRID_BAR(); } while (0)

    if (IN(0)) { ph_mods(F); ph_small(F); __syncthreads(); ph_transposes(F); ph_weff(F); }
    SEAM(0);
    if (IN(1)) { ph_bias(F); ph_norm_mod(F); }
    SEAM(1);
    if (IN(2)) { gemm_naive_phase(F, F.A0, F.Win0, EVN, 1024, 0, ROWS, EpiStore{F.P0, EVN}); GRID_BAR(); ph_rope(F); }
    SEAM(2);
    if (IN(3)) { ph_attn_naive(F); ph_pool_d(F); GRID_BAR(); ph_readout0(F); }
    SEAM(3);
    if (IN(4)) { gemm_naive_phase(F, F.A1, F.Wout0, 1024, 1024, 0, ROWS, EpiResid{F.x, F.ctx, F.out, F.xc, F.mods + 2 * 1024, F.mods + 4 * 1024, F.A0}); GRID_BAR(); ph_rowssq(F, ROWS); }
    SEAM(4);
    if (IN(5)) { for (int c0 = 0; c0 < ROWS; c0 += 4608) { const int c1 = c0 + 4608, rb = c0 - 1, re = c1 + 1 > ROWS ? ROWS : c1 + 1;
            gemm_naive_phase(F, F.A0, F.Wup0, FF2, 1024, rb, re, EpiUp{F.UCH, rb, F.ssq, F.bup}); GRID_BAR(); ph_convgate(F, 0, rb, c0, c1); if (c1 < ROWS) GRID_BAR(); } }
    SEAM(5);
    if (IN(6)) { gemm_naive_phase(F, F.G, F.Wdn0, 1024, FF, 0, ROWS, EpiResid{F.out, F.xc, F.out, F.xc, F.mods + 5 * 1024, F.mods + 9 * 6144 + 1 * 1024, F.A0}); GRID_BAR(); ph_rowssq(F, ROWS); }
    SEAM(6);
    if (IN(7)) gemm_naive_phase(F, F.A0, F.Win1, HGN, 1024, 0, ROWS, EpiIn1{F.ssq, F.bin1, F.misc + 1024, F.Q1, F.GG1, F.V1, F.LF1, F.LB1});
    SEAM(7);
    if (IN(8)) { ph_scan_naive(F, 0); GRID_BAR(); ph_scan_naive(F, 1); }
    SEAM(8);
    if (IN(9)) ph_combine1(F);
    SEAM(9);
    if (IN(10)) { gemm_naive_phase(F, F.A3, F.Wout1, 1024, 1024, 0, LAT, EpiResid{F.out, F.xc, F.out, F.xc, F.mods + 9 * 6144 + 2 * 1024, F.mods + 9 * 6144 + 4 * 1024, F.A0}); GRID_BAR(); ph_rowssq(F, LAT); }
    SEAM(10);
    if (IN(11)) { for (int c0 = 0; c0 < LAT; c0 += 4608) { const int c1 = c0 + 4608 > LAT ? LAT : c0 + 4608, rb = c0 - 1, re = c1 + 1;
            gemm_naive_phase(F, F.A0, F.Wup1, FF2, 1024, rb, re, EpiUp{F.UCH, rb, F.ssq, F.bup + 9 * FF2}); GRID_BAR(); ph_convgate(F, 1, rb, c0, c1); if (c1 < LAT) GRID_BAR(); } }
    SEAM(11);
    if (IN(12)) gemm_naive_phase(F, F.G, F.Wdn1, 1024, FF, 0, LAT, EpiResid{F.out, F.xc, F.out, F.xc, F.mods + 9 * 6144 + 5 * 1024, nullptr, nullptr});
    SEAM(12);
    if (IN(13)) ph_final(F);
}

extern "C" void kernel_launch(void* const* d_in, const int* in_sizes, int n_in, void* d_out, int out_size, void* d_ws, size_t ws_size, hipStream_t st) {
    static int grid = 0;
    if (grid == 0) {
        if (n_in != 24 || ws_size < WS_END || out_size != LAT * D) { fprintf(stderr, "kernel_launch: unexpected shapes (n_in %d, ws %zu, out %d)\n", n_in, ws_size, out_size); grid = -1; return; }
        int dev = 0, cus = 0;
        if (hipGetDevice(&dev) != hipSuccess || hipDeviceGetAttribute(&cus, hipDeviceAttributeMultiprocessorCount, dev) != hipSuccess) { grid = -1; return; }
        if (hipFuncSetAttribute((const void*)mk_fwd, hipFuncAttributeMaxDynamicSharedMemorySize, LDS_BYTES) != hipSuccess) { fprintf(stderr, "kernel_launch: hipFuncSetAttribute failed\n"); grid = -1; return; }
        int per_cu = 0; (void)hipOccupancyMaxActiveBlocksPerMultiprocessor(&per_cu, (const void*)mk_fwd, NTHR, LDS_BYTES); (void)hipGetLastError();
        if (per_cu < 1) fprintf(stderr, "kernel_launch: occupancy query reports %d\n", per_cu);
        grid = cus;
    }
    if (grid < 0) return;
    (void)hipMemsetAsync((char*)d_ws + OFF_CTL, 0, CTL_ZERO_BYTES, st);
    Args a{};
    for (int i = 0; i < 24; ++i) a.in[i] = (const float*)d_in[i];
    a.out = (float*)d_out; a.ws = (unsigned char*)d_ws; a.ph_lo = 0; a.ph_hi = NPHASE;
    hipLaunchKernelGGL(mk_fwd, dim3(grid), dim3(NTHR), LDS_BYTES, st, a);
}
```

```cpp
#include <hip/hip_runtime.h>
#include <cstdint>
#include <cstdio>

typedef unsigned short bf16_t;
typedef _Float16 f16_t;

namespace cfg {
constexpr int D = 1024, BATCH = 8, SEQ = 2048, CTXL = 256;
constexpr int LAT = BATCH * SEQ, CTXR = BATCH * CTXL, ROWS = LAT + CTXR;
constexpr int EVN = 2048, HGN = 5120, FF = 2816, FF2 = 5632;
constexpr float EPS = 1e-6f;
constexpr float QSCALE = 0.125f * 1.4426950408889634f;
constexpr size_t MiB = 1u << 20;
constexpr size_t OFF_CTL = 0, CTL_ZERO_BYTES = 64 * 1024;
constexpr size_t OFF_MODS = 1 * MiB;
constexpr size_t OFF_ROPE = 1 * MiB + 512 * 1024;
constexpr size_t OFF_MISC = OFF_ROPE + 8192;
constexpr size_t OFF_BUP = 2 * MiB;
constexpr size_t OFF_BIN1 = 2 * MiB + 512 * 1024;
constexpr size_t OFF_SSQ = 2 * MiB + 768 * 1024;
constexpr size_t OFF_WIN1 = 4 * MiB, OFF_WOUT1 = 14 * MiB, OFF_WUP1 = 16 * MiB, OFF_WDN1 = 27 * MiB;
constexpr size_t OFF_XC = 32 * MiB + 512 * 1024;
constexpr size_t OFF_A = 41 * MiB;
constexpr size_t OFF_WIN0 = 78 * MiB, OFF_WOUT0 = 82 * MiB, OFF_WUP0 = 84 * MiB, OFF_WDN0 = 95 * MiB;
constexpr size_t OFF_B = 100 * MiB + 512 * 1024;
constexpr size_t OFF_P0 = OFF_B;
constexpr size_t OFF_A1 = OFF_B + 72 * MiB;
constexpr size_t OFF_ON = OFF_A1 + 36 * MiB;
constexpr size_t OFF_G = OFF_B;
constexpr size_t OFF_UCH = OFF_B + 99 * MiB;
constexpr size_t OFF_Q1 = 78 * MiB, OFF_GG1 = 110 * MiB, OFF_V1 = 142 * MiB, OFF_LF1 = 178 * MiB, OFF_LB1 = 214 * MiB;
constexpr size_t OFF_OSUM = OFF_A;
constexpr size_t OFF_A3 = OFF_Q1;
constexpr size_t WS_END = 256 * MiB;
static_assert(OFF_ON + 36 * MiB <= WS_END && OFF_UCH + (size_t)4610 * 5632 * 2 <= WS_END && OFF_LB1 + 36 * MiB <= WS_END, "ws map");
constexpr int NTHR = 512, LDS_BYTES = 147456;
constexpr int LDS_MISC = 140 * 1024;
}
using namespace cfg;

#define GAS __attribute__((address_space(1)))
#define LAS __attribute__((address_space(3)))
__device__ __forceinline__ float bf2f(bf16_t v) { return __uint_as_float((unsigned)v << 16); }
__device__ __forceinline__ bf16_t f2bf(float f) { unsigned u = __float_as_uint(f); return (bf16_t)((u + 0x7fffu + ((u >> 16) & 1u)) >> 16); }
__device__ __forceinline__ unsigned pk2(float lo, float hi) { return (unsigned)f2bf(lo) | ((unsigned)f2bf(hi) << 16); }
__device__ __forceinline__ float silu_f(float x) { return x / (1.f + expf(-x)); }
__device__ __forceinline__ float wave_sum(float v) {
#pragma unroll
    for (int o = 1; o < 64; o <<= 1) v += __shfl_xor(v, o);
    return v;
}
__device__ __forceinline__ int mod_row(int row) { return row < LAT ? (row >> 11) : 8; }
__device__ __forceinline__ float rstd_of(const float* ssq, int row) { const float4* p = (const float4*)(ssq + (size_t)row * 16); float t = 0.f;
#pragma unroll
    for (int i = 0; i < 4; ++i) { const float4 s = p[i]; t += (s.x + s.y) + (s.z + s.w); }
    return rsqrtf(t * (1.f / D) + EPS); }

#define XB_TMO      128
#define XB_XCNT(j)  (256  + 64 * (j))
#define XB_XSUB(j)  (1280 + 64 * (j))
#define XB_XGEN(j)  (2304 + 64 * (j))
#define XB_TOP      3328
#define XB_TOPGEN   3392
#define XCD_BAR_WORDS 3456
#define XB_SPIN_CAP (1u << 18)
__device__ __forceinline__ unsigned xb_ld(unsigned* p)              { return __hip_atomic_load(p, __ATOMIC_RELAXED, __HIP_MEMORY_SCOPE_AGENT); }
__device__ __forceinline__ unsigned xb_add(unsigned* p, unsigned v) { return __hip_atomic_fetch_add(p, v, __ATOMIC_RELAXED, __HIP_MEMORY_SCOPE_AGENT); }
__device__ __forceinline__ unsigned xb_xcc_id() { return (unsigned)__builtin_amdgcn_s_getreg((3 << 11) | 20) & 0xFu; }
#define XB_SPIN(cond, bar) do { unsigned _sp = 0; while (cond) { __builtin_amdgcn_s_sleep(1); \
    if ((++_sp & 255u) == 0u) { if (xb_ld(&(bar)[XB_TMO])) break; if (_sp > XB_SPIN_CAP) { atomicAdd(&(bar)[XB_TMO], 1u); break; } } } } while (0)
struct XcdBarrier { unsigned* bar; unsigned x; volatile LAS unsigned* st; };
__device__ __forceinline__ XcdBarrier xcd_barrier_post(unsigned* bar, volatile LAS unsigned* st) {
    XcdBarrier b; b.bar = bar; b.x = xb_xcc_id(); b.st = st;
    if (threadIdx.x == 0) (void)xb_add(&bar[XB_XCNT(b.x)], 1u);
    return b;
}
__device__ __forceinline__ void xcd_barrier_complete(unsigned* bar, unsigned x, unsigned& nloc, unsigned& nx) {
    const unsigned G = gridDim.x * gridDim.y * gridDim.z;
    unsigned sum, cnt, mine, sp = 0u;
    for (;;) {
        sum = 0u; cnt = 0u; mine = 0u;
#pragma unroll
        for (unsigned j = 0; j < 16; ++j) { const unsigned c = xb_ld(&bar[XB_XCNT(j)]); sum += c; cnt += (c > 0u) ? 1u : 0u; mine = (j == x) ? c : mine; }
        if (sum == G) break;
        __builtin_amdgcn_s_sleep(1);
        if ((++sp & 255u) == 0u) { if (xb_ld(&bar[XB_TMO])) break; if (sp > XB_SPIN_CAP) { atomicAdd(&bar[XB_TMO], 1u); break; } }
    }
    nloc = mine > 0u ? mine : 1u; nx = cnt > 0u ? cnt : 1u;
}
__device__ __forceinline__ void xcd_barrier(const XcdBarrier& b) {
    asm volatile("s_waitcnt vmcnt(0)" ::: "memory");
    __syncthreads();
    if (threadIdx.x == 0) {
        unsigned* bar = b.bar;
        __builtin_amdgcn_s_waitcnt(0);
        unsigned nloc = b.st[0], nx = b.st[1];
        if (nloc == 0u) { xcd_barrier_complete(bar, b.x, nloc, nx); b.st[0] = nloc; b.st[1] = nx; }
        const unsigned old = xb_add(&bar[XB_XSUB(b.x)], 1u);
        const unsigned gen = old / nloc;
        if (old + 1u == (gen + 1u) * nloc) {
            __builtin_amdgcn_fence(__ATOMIC_RELEASE, "agent");
            asm volatile("s_waitcnt vmcnt(0)" ::: "memory");
            const unsigned og = xb_add(&bar[XB_TOP], 1u);
            const unsigned tg = og / nx;
            if (og + 1u == (tg + 1u) * nx) xb_add(&bar[XB_TOPGEN], 1u);
            else XB_SPIN(xb_ld(&bar[XB_TOPGEN]) == tg, bar);
            __builtin_amdgcn_fence(__ATOMIC_ACQUIRE, "agent");
            xb_add(&bar[XB_XGEN(b.x)], 1u);
            asm volatile("s_waitcnt vmcnt(0)" ::: "memory");
        } else {
            XB_SPIN(xb_ld(&bar[XB_XGEN(b.x)]) == gen, bar);
            __builtin_amdgcn_fence(__ATOMIC_ACQUIRE, "agent");
            asm volatile("s_waitcnt vmcnt(0)" ::: "memory");
        }
    }
    __syncthreads();
}

struct Args { const float* in[24]; float* out; unsigned char* ws; int ph_lo, ph_hi; };
struct Frame {
    const Args& A; LAS unsigned char* lds; int tid, lane, wave, gw, NGW, gt, NGT;
    __device__ __forceinline__ Frame(const Args& a) : A(a) {}
    __device__ __forceinline__ const float* x() const { return A.in[0]; }
    __device__ __forceinline__ const float* c() const { return A.in[1]; }
    __device__ __forceinline__ const float* ctx() const { return A.in[2]; }
    __device__ __forceinline__ const float* c_ctx() const { return A.in[3]; }
    __device__ __forceinline__ const float* w_mod() const { return A.in[4]; }
    __device__ __forceinline__ const float* b_mod() const { return A.in[5]; }
    __device__ __forceinline__ const float* ev_w_in() const { return A.in[6]; }
    __device__ __forceinline__ const float* ev_w_out() const { return A.in[7]; }
    __device__ __forceinline__ const float* lq1() const { return A.in[8]; }
    __device__ __forceinline__ const float* lk1() const { return A.in[9]; }
    __device__ __forceinline__ const float* lq2() const { return A.in[10]; }
    __device__ __forceinline__ const float* lk2() const { return A.in[11]; }
    __device__ __forceinline__ const float* subln() const { return A.in[12]; }
    __device__ __forceinline__ const float* pool_w() const { return A.in[13]; }
    __device__ __forceinline__ const float* pool_scale() const { return A.in[14]; }
    __device__ __forceinline__ const float* hg_w_in() const { return A.in[15]; }
    __device__ __forceinline__ const float* hg_w_out() const { return A.in[16]; }
    __device__ __forceinline__ const float* lb_logits() const { return A.in[17]; }
    __device__ __forceinline__ const float* hg_norm() const { return A.in[18]; }
    __device__ __forceinline__ const float* w_up() const { return A.in[19]; }
    __device__ __forceinline__ const float* conv_w() const { return A.in[20]; }
    __device__ __forceinline__ const float* conv_b() const { return A.in[21]; }
    __device__ __forceinline__ const float* w_down() const { return A.in[22]; }
    __device__ __forceinline__ const float* final_norm() const { return A.in[23]; }
    __device__ __forceinline__ float* out() const { return A.out; }
    __device__ __forceinline__ unsigned char* ws() const { return A.ws; }
    __device__ __forceinline__ float* mods() const { return (float*)(A.ws + OFF_MODS); }
    __device__ __forceinline__ float* rope() const { return (float*)(A.ws + OFF_ROPE); }
    __device__ __forceinline__ float* misc() const { return (float*)(A.ws + OFF_MISC); }
    __device__ __forceinline__ float* ssq() const { return (float*)(A.ws + OFF_SSQ); }
    __device__ __forceinline__ float* bup() const { return (float*)(A.ws + OFF_BUP); }
    __device__ __forceinline__ float* bin1() const { return (float*)(A.ws + OFF_BIN1); }
    __device__ __forceinline__ float* xc() const { return (float*)(A.ws + OFF_XC); }
    __device__ __forceinline__ bf16_t* Win0() const { return (bf16_t*)(A.ws + OFF_WIN0); }
    __device__ __forceinline__ bf16_t* Wout0() const { return (bf16_t*)(A.ws + OFF_WOUT0); }
    __device__ __forceinline__ bf16_t* Wup0() const { return (bf16_t*)(A.ws + OFF_WUP0); }
    __device__ __forceinline__ bf16_t* Wdn0() const { return (bf16_t*)(A.ws + OFF_WDN0); }
    __device__ __forceinline__ bf16_t* Win1() const { return (bf16_t*)(A.ws + OFF_WIN1); }
    __device__ __forceinline__ bf16_t* Wout1() const { return (bf16_t*)(A.ws + OFF_WOUT1); }
    __device__ __forceinline__ bf16_t* Wup1() const { return (bf16_t*)(A.ws + OFF_WUP1); }
    __device__ __forceinline__ bf16_t* Wdn1() const { return (bf16_t*)(A.ws + OFF_WDN1); }
    __device__ __forceinline__ bf16_t* A0() const { return (bf16_t*)(A.ws + OFF_A); }
    __device__ __forceinline__ bf16_t* A1() const { return (bf16_t*)(A.ws + OFF_A1); }
    __device__ __forceinline__ bf16_t* P0() const { return (bf16_t*)(A.ws + OFF_P0); }
    __device__ __forceinline__ bf16_t* ON() const { return (bf16_t*)(A.ws + OFF_ON); }
    __device__ __forceinline__ bf16_t* G() const { return (bf16_t*)(A.ws + OFF_G); }
    __device__ __forceinline__ bf16_t* UCH() const { return (bf16_t*)(A.ws + OFF_UCH); }
    __device__ __forceinline__ bf16_t* Q1() const { return (bf16_t*)(A.ws + OFF_Q1); }
    __device__ __forceinline__ bf16_t* GG1() const { return (bf16_t*)(A.ws + OFF_GG1); }
    __device__ __forceinline__ bf16_t* V1() const { return (bf16_t*)(A.ws + OFF_V1); }
    __device__ __forceinline__ bf16_t* OSUM() const { return (bf16_t*)(A.ws + OFF_OSUM); }
    __device__ __forceinline__ bf16_t* A3() const { return (bf16_t*)(A.ws + OFF_A3); }
    __device__ __forceinline__ f16_t* LF1() const { return (f16_t*)(A.ws + OFF_LF1); }
    __device__ __forceinline__ f16_t* LB1() const { return (f16_t*)(A.ws + OFF_LB1); }
};

__device__ __forceinline__ void ph_mods(Frame& F) {
    LAS float* s = (LAS float*)F.lds;
    LAS float* red = (LAS float*)(F.lds + 36864);
    if ((int)blockIdx.x >= 192) return;
    for (int i = F.tid; i < 9 * 1024; i += NTHR) { const int r = i >> 10, k = i & 1023; s[i] = silu_f(r < 8 ? F.c()[r * 1024 + k] : F.c_ctx()[k]); }
    __syncthreads();
    const int kg = F.tid >> 6, cl = F.tid & 63;
    for (int item = blockIdx.x; item < 192; item += gridDim.x) {
        const int l = item / 96, col = (item % 96) * 64 + cl;
        float acc[9];
#pragma unroll
        for (int r = 0; r < 9; ++r) acc[r] = 0.f;
        const float* w = F.w_mod() + (size_t)l * 1024 * 6144 + col;
        for (int k = kg * 128; k < kg * 128 + 128; ++k) { const float wv = w[(size_t)k * 6144];
#pragma unroll
            for (int r = 0; r < 9; ++r) acc[r] += s[r * 1024 + k] * wv; }
#pragma unroll
        for (int r = 0; r < 9; ++r) red[(kg * 9 + r) * 64 + cl] = acc[r];
        __syncthreads();
        if (kg == 0) {
#pragma unroll
            for (int r = 0; r < 9; ++r) { float t = 0.f;
#pragma unroll
                for (int g = 0; g < 8; ++g) t += red[(g * 9 + r) * 64 + cl];
                F.mods()[((size_t)l * 9 + r) * 6144 + col] = F.b_mod()[l * 6144 + col] + t; }
        }
        __syncthreads();
    }
}
__device__ __forceinline__ void ph_small(Frame& F) {
    if (blockIdx.x != gridDim.x - 1) return;
    const int tid = F.tid;
    if (tid == 0) { float s1 = 0.f, s2 = 0.f; for (int i = 0; i < 64; ++i) { s1 += F.lq1()[i] * F.lk1()[i]; s2 += F.lq2()[i] * F.lk2()[i]; } F.misc()[0] = expf(s1) - expf(s2) + 0.2f; }
    F.misc()[64 + tid] = F.subln()[tid] * 0.8f;
    for (int i = tid; i < 2048; i += NTHR) { const int dir = i >> 10, ch = i & 1023; const float l0 = F.lb_logits()[(dir * 2 + 0) * 1024 + ch], l1 = F.lb_logits()[(dir * 2 + 1) * 1024 + ch];
        const float m = fmaxf(l0, l1), e0 = expf(l0 - m), e1 = expf(l1 - m); F.misc()[1024 + i] = e1 / (e0 + e1); }
    for (int i = tid; i < 1024; i += NTHR) { const int pos = i >> 4, f = i & 15; const float inv = powf(10000.0f, -(float)f / 16.0f); const float ang = (float)pos * inv; F.rope()[i] = cosf(ang); F.rope()[1024 + i] = sinf(ang); }
}
__device__ __forceinline__ void transpose_item(const float* W, int K, int N, bf16_t* WT, int ldt, int mode, LAS float* scr, int item, int lane) {
    const int nblk = N / 32, kb = item / nblk, nb = item % nblk, k0 = 64 * kb, n0 = 32 * nb;
#pragma unroll 8
    for (int i = 0; i < 32; ++i) { const int kk = 2 * i + (lane >> 5); scr[kk * 33 + (lane & 31)] = W[(size_t)(k0 + kk) * N + n0 + (lane & 31)]; }
    asm volatile("s_waitcnt lgkmcnt(0)" ::: "memory");
    const int c = lane & 7;
#pragma unroll
    for (int j = 0; j < 4; ++j) { const int nn = (lane >> 3) + 8 * j; const LAS float* s = scr + (8 * c) * 33 + nn;
        uint4 o; o.x = pk2(s[0 * 33], s[1 * 33]); o.y = pk2(s[2 * 33], s[3 * 33]); o.z = pk2(s[4 * 33], s[5 * 33]); o.w = pk2(s[6 * 33], s[7 * 33]);
        const int n = n0 + nn; int np = n;
        if (mode == 1) { const int ch = n < FF ? n : n - FF; np = (ch >> 7) * 256 + (ch & 127) + (n < FF ? 0 : 128); }
        *(uint4*)(WT + (size_t)np * ldt + k0 + 8 * c) = o; }
    asm volatile("s_waitcnt lgkmcnt(0)" ::: "memory");
}
__device__ __forceinline__ void ph_transposes(Frame& F) {
    LAS float* scr = (LAS float*)(F.lds + 57344 + F.wave * 8448);
    constexpr int I0 = 16 * 64, I1 = 8 * 32, I2 = 16 * 176, I3 = 44 * 32, I4 = 16 * 160, I5 = 16 * 32, I6 = I2, I7 = I3;
    constexpr int NIT = I0 + I1 + I2 + I3 + I4 + I5 + I6 + I7;
    for (int it = F.gw; it < NIT; it += F.NGW) {
        int r = it;
        if (r < I0) { transpose_item(F.ev_w_in(), 1024, EVN, F.Win0(), 1024, 0, scr, r, F.lane); continue; } r -= I0;
        if (r < I1) { transpose_item(F.ev_w_out(), 512, 1024, F.Wout0(), 1024, 0, scr, r, F.lane); continue; } r -= I1;
        if (r < I2) { transpose_item(F.w_up(), 1024, FF2, F.Wup0(), 1024, 1, scr, r, F.lane); continue; } r -= I2;
        if (r < I3) { transpose_item(F.w_down(), FF, 1024, F.Wdn0(), FF, 0, scr, r, F.lane); continue; } r -= I3;
        if (r < I4) { transpose_item(F.hg_w_in(), 1024, HGN, F.Win1(), 1024, 0, scr, r, F.lane); continue; } r -= I4;
        if (r < I5) { transpose_item(F.hg_w_out(), 1024, 1024, F.Wout1(), 1024, 0, scr, r, F.lane); continue; } r -= I5;
        if (r < I6) { transpose_item(F.w_up() + (size_t)1024 * FF2, 1024, FF2, F.Wup1(), 1024, 1, scr, r, F.lane); continue; } r -= I6;
        transpose_item(F.w_down() + (size_t)FF * 1024, FF, 1024, F.Wdn1(), FF, 0, scr, r, F.lane);
    }
}
__device__ __forceinline__ void ph_weff(Frame& F) {
    for (int idx = F.gt; idx < 512 * 1024; idx += F.NGT) { const int gc = idx >> 10, n = idx & 1023, g = gc >> 7;
        float acc = 0.f;
        for (int d = 0; d < 128; ++d) acc += F.pool_w()[(size_t)gc * 128 + d] * F.pool_scale()[g * 128 + d] * F.ev_w_out()[(size_t)(512 + g * 128 + d) * 1024 + n];
        F.Wout0()[(size_t)n * 1024 + 512 + gc] = f2bf(acc); }
}
__device__ __forceinline__ void bias_item(const float* mods_l, int chunk, const bf16_t* Wt, int N, float* bias, int n, int lane) {
    float acc[9];
#pragma unroll
    for (int r = 0; r < 9; ++r) acc[r] = 0.f;
    for (int k = lane; k < 1024; k += 64) { const float w = bf2f(Wt[(size_t)n * 1024 + k]);
#pragma unroll
        for (int r = 0; r < 9; ++r) acc[r] += mods_l[(size_t)r * 6144 + chunk * 1024 + k] * w; }
#pragma unroll
    for (int r = 0; r < 9; ++r) { const float s = wave_sum(acc[r]); if (lane == 0) bias[(size_t)r * N + n] = s; }
}
__device__ __forceinline__ void ph_bias(Frame& F) {
    for (int it = F.gw; it < 2 * FF2 + HGN; it += F.NGW) {
        if (it < FF2) bias_item(F.mods(), 3, F.Wup0(), FF2, F.bup(), it, F.lane);
        else if (it < 2 * FF2) bias_item(F.mods() + 9 * 6144, 3, F.Wup1(), FF2, F.bup() + 9 * FF2, it - FF2, F.lane);
        else bias_item(F.mods() + 9 * 6144, 0, F.Win1(), HGN, F.bin1(), it - 2 * FF2, F.lane);
    }
}
__device__ __forceinline__ void ph_norm_mod(Frame& F) {
    for (int row = F.gw; row < ROWS; row += F.NGW) {
        const float* xr = row < LAT ? F.x() + (size_t)row * D : F.ctx() + (size_t)(row - LAT) * D;
        const float* m = F.mods() + (size_t)mod_row(row) * 6144;
        float4 v[4]; float s = 0.f;
#pragma unroll
        for (int j = 0; j < 4; ++j) { v[j] = *(const float4*)(xr + j * 256 + F.lane * 4); s += (v[j].x * v[j].x + v[j].y * v[j].y) + (v[j].z * v[j].z + v[j].w * v[j].w); }
        const float rstd = rsqrtf(wave_sum(s) * (1.f / D) + EPS);
#pragma unroll
        for (int j = 0; j < 4; ++j) { const int c0 = j * 256 + F.lane * 4; const float4 sh = *(const float4*)(m + c0), sc = *(const float4*)(m + 1024 + c0);
            uint2 o; o.x = pk2(v[j].x * rstd * (1.f + sc.x) + sh.x, v[j].y * rstd * (1.f + sc.y) + sh.y); o.y = pk2(v[j].z * rstd * (1.f + sc.z) + sh.z, v[j].w * rstd * (1.f + sc.w) + sh.w);
            *(uint2*)(F.A0() + (size_t)row * D + c0) = o; }
    }
}
__device__ __forceinline__ void ph_rowssq(Frame& F, int nrows) {
    for (int row = F.gw; row < nrows; row += F.NGW) {
        const float* xr = row < LAT ? F.out() + (size_t)row * D : F.xc() + (size_t)(row - LAT) * D;
        float s = 0.f;
#pragma unroll
        for (int j = 0; j < 4; ++j) { const float4 v = *(const float4*)(xr + j * 256 + F.lane * 4); s += (v.x * v.x + v.y * v.y) + (v.z * v.z + v.w * v.w); }
        s = wave_sum(s);
        if (F.lane < 16) F.ssq()[(size_t)row * 16 + F.lane] = F.lane == 0 ? s : 0.f;
    }
}

template <class Epi>
__device__ __forceinline__ void gemm_naive_phase(Frame& F, const bf16_t* A, const bf16_t* Bt, int N, int K, int rowBeg, int rowEnd, const Epi& epi) {
    const int half = F.tid >> 8, tid = F.tid & 255, tx = tid & 15, ty = tid >> 4;
    LAS float* As = (LAS float*)(F.lds + half * 8320); LAS float* Bs = As + 16 * 65;
    const int tn = N / 64, tm = (rowEnd - rowBeg + 63) / 64, ntiles = tn * tm;
    const int lr = tid >> 2, lk = (tid & 3) * 4;
    for (int i = blockIdx.x; 2 * i < ntiles; i += gridDim.x) {
        const int tile = 2 * i + half, r0 = rowBeg + (tile / tn) * 64, c0 = (tile % tn) * 64;
        float acc[4][4];
#pragma unroll
        for (int a = 0; a < 4; ++a)
#pragma unroll
            for (int b = 0; b < 4; ++b) acc[a][b] = 0.f;
        int arow = r0 + lr; if (arow > rowEnd - 1) arow = rowEnd - 1;
        const bf16_t* ap = A + (long)arow * K + lk;
        const bf16_t* bp = Bt + (size_t)(c0 + lr) * K + lk;
        for (int k0 = 0; k0 < K; k0 += 16) {
            const ushort4 av = *(const ushort4*)(ap + k0), bv = *(const ushort4*)(bp + k0);
            As[(lk + 0) * 65 + lr] = bf2f(av.x); As[(lk + 1) * 65 + lr] = bf2f(av.y); As[(lk + 2) * 65 + lr] = bf2f(av.z); As[(lk + 3) * 65 + lr] = bf2f(av.w);
            Bs[(lk + 0) * 65 + lr] = bf2f(bv.x); Bs[(lk + 1) * 65 + lr] = bf2f(bv.y); Bs[(lk + 2) * 65 + lr] = bf2f(bv.z); Bs[(lk + 3) * 65 + lr] = bf2f(bv.w);
            __syncthreads();
#pragma unroll
            for (int k = 0; k < 16; ++k) { float a[4], b[4];
#pragma unroll
                for (int q = 0; q < 4; ++q) { a[q] = As[k * 65 + ty * 4 + q]; b[q] = Bs[k * 65 + tx * 4 + q]; }
#pragma unroll
                for (int q = 0; q < 4; ++q)
#pragma unroll
                    for (int j = 0; j < 4; ++j) acc[q][j] += a[q] * b[j]; }
            __syncthreads();
        }
#pragma unroll
        for (int q = 0; q < 4; ++q) { const int row = r0 + ty * 4 + q; if (row < rowEnd) {
#pragma unroll
            for (int j = 0; j < 4; ++j) epi(row, c0 + tx * 4 + j, acc[q][j]); } }
    }
}
struct EpiStore { bf16_t* C; long long ldc; __device__ void operator()(int row, int col, float v) const { C[(size_t)row * ldc + col] = f2bf(v); } };
struct EpiUp { bf16_t* U; long long rowBase; const float* ssq; const float* bias;
    __device__ void operator()(int row, int col, float v) const { if (row < 0 || row >= ROWS) return; U[(size_t)(row - rowBase) * FF2 + col] = f2bf(rstd_of(ssq, row) * v + bias[(size_t)mod_row(row) * FF2 + col]); } };
struct EpiResid { const float* xin_lat; const float* xin_ctx; float* xout_lat; float* xout_ctx; const float* gate; const float* scale_next; bf16_t* An;
    __device__ void operator()(int row, int col, float v) const {
        const int r = mod_row(row); const size_t o = row < LAT ? (size_t)row * D + col : (size_t)(row - LAT) * D + col;
        const float xo = (row < LAT ? xin_lat : xin_ctx)[o]; const float xn = xo + gate[(size_t)r * 6144 + col] * v;
        (row < LAT ? xout_lat : xout_ctx)[o] = xn;
        if (An) An[(size_t)row * D + col] = f2bf(xn * (1.f + scale_next[(size_t)r * 6144 + col])); } };
struct EpiIn1 { const float* ssq; const float* bias; const float* lbv; bf16_t* Q; bf16_t* GG; bf16_t* V; f16_t* LF; f16_t* LB;
    __device__ void operator()(int row, int col, float acc) const {
        const int blk = col >> 10, ch = col & 1023; const float val = rstd_of(ssq, row) * acc + bias[(size_t)mod_row(row) * HGN + col];
        if (blk == 0) { if (row < LAT) Q[(size_t)row * D + ch] = f2bf(silu_f(val)); }
        else if (blk == 1) V[(size_t)row * D + ch] = f2bf(val);
        else if (blk == 4) { if (row < LAT) GG[(size_t)row * D + ch] = f2bf(silu_f(val)); }
        else { const float lb = lbv[(blk - 2) * 1024 + ch]; const float f = lb + (1.f - lb) / (1.f + expf(-val)); (blk == 2 ? LF : LB)[(size_t)row * D + ch] = (f16_t)logf(f); } } };


namespace pg8 {
#define PG8_LAS __attribute__((address_space(3)))
typedef unsigned short bf16_t;
typedef short bf16x8 __attribute__((ext_vector_type(8)));
typedef float f32x4 __attribute__((ext_vector_type(4)));
typedef unsigned u32x4 __attribute__((ext_vector_type(4)));
constexpr int BM = 256, BK = 64, HALF = 128, HTB = HALF * BK * 2  , STAGE_BYTES = 8 * HTB, NXCD = 8, WGM = 8;

__host__ __device__ __forceinline__ int lds_byte(int r, int c) { const int st = (r >> 4) * 2 + (c >> 5), rr = r & 15, cc = c & 31, ob = rr * 64 + cc * 2; return st * 1024 + (ob ^ (((ob >> 9) & 1) << 5)); }
__host__ __device__ __forceinline__ void stage_rc(int b, int& R, int& C) { const int st = b / 1024, sb = b % 1024, swz = sb ^ (((sb >> 9) & 1) << 5); R = (st >> 1) * 16 + swz / 64; C = (st & 1) * 32 + (swz % 64) / 2; }
__host__ __device__ __forceinline__ int perm32(int rho) { const int n = rho >> 4, i = rho & 15; return 8 * (i >> 2) + 4 * n + (i & 3); }

struct Unit { int pm, pn; };
struct Gemm { const bf16_t* A; const bf16_t* Bt; int M, N, K; int achunk; };

struct StaticOrder {
    int nM, nN, nwg, G, c;
    __host__ __device__ void init(int M, int N, int G_, int c_) { nM = M / BM; nN = N / BM; nwg = nM * nN; G = G_; c = c_; }
    __host__ __device__ void init2(int nM_, int nN_, int G_, int c_) { nM = nM_; nN = nN_; nwg = nM * nN; G = G_; c = c_; }
    __host__ __device__ bool next(int i, Unit& u) const {
        const long L = (long)i * G + c; if (L >= nwg) return false;
        int wgid = (int)L; { const int q = nwg / NXCD, r = nwg % NXCD, xcd = wgid % NXCD, off = wgid / NXCD; wgid = (xcd < r ? xcd * (q + 1) : r * (q + 1) + (xcd - r) * q) + off; }
        const int nig = WGM * nN, gid = wgid / nig, fm = gid * WGM, gsz = (nM - fm) < WGM ? (nM - fm) : WGM;
        u.pm = fm + ((wgid % nig) % gsz); u.pn = (wgid % nig) / gsz; return true;
    }
    __device__ __forceinline__ void a_ready(const Unit&) const {}
    __device__ __forceinline__ void done(const Unit&) const {}
};
template <class Epi, class Sched, bool ALIGN_EPI = false, bool SP2 = false>
__device__ __forceinline__ void gemm_phase(PG8_LAS unsigned char* lds, const Gemm g, const Sched& S, const Epi& E) {
    const int tid = threadIdx.x, wid = __builtin_amdgcn_readfirstlane(tid >> 6), lane = tid & 63, wr = wid >> 2, wc = wid & 3, fr = lane & 15, fq = lane >> 4;
    const int K = g.K, nt = K / BK;
    unsigned voffA[2], voffB[2];
#pragma unroll
    for (int i = 0; i < 2; ++i) { int R, C; stage_rc(tid * 16 + i * 8192, R, C); const int Rb = Epi::PERM ? ((R & ~31) + perm32(R & 31)) : R;
        const int Ra = g.achunk ? (62 * (R >> 6) + 4 * (R & 15) + ((R >> 4) & 3)) : R;
        voffA[i] = (unsigned)(Ra * K + C) * 2u; voffB[i] = (unsigned)(Rb * K + C) * 2u; }
    const size_t kstep = (size_t)(BK * 2);
    const size_t hstep = (size_t)HALF * K * 2;
    const size_t tstep = 2 * hstep;
    const size_t hstepA = g.achunk ? (size_t)124 * K * 2 : hstep, tstepA = 2 * hstepA;
    const unsigned ldsw = (unsigned)wid * 1024u;
    const int aoff = lds_byte(wr * 64 + fr, fq * 8), boff = lds_byte(wc * 32 + fr, fq * 8);
#define PG8_SA(b, h) (((b) * 2 + (h)) * HTB)
#define PG8_SB(b, h) ((4 + (b) * 2 + (h)) * HTB)
#define PG8_STAGE(bufoff, gbase, voff) do { _Pragma("unroll") for (int _i = 0; _i < 2; ++_i) \
        __builtin_amdgcn_global_load_lds((const unsigned*)((const char*)(gbase) + (voff)[_i]), (PG8_LAS unsigned*)(lds + (bufoff) + ldsw + _i * 8192), 16, 0, 0); } while (0)
#define PG8_LDA(dst, b, h) do { _Pragma("unroll") for (int m = 0; m < 4; ++m) _Pragma("unroll") for (int k = 0; k < 2; ++k) dst[m][k] = *(const PG8_LAS bf16x8*)(lds + PG8_SA(b, h) + aoff + m * 2048 + k * 1024); } while (0)
#define PG8_LDB(dst, b, h) do { _Pragma("unroll") for (int n = 0; n < 2; ++n) _Pragma("unroll") for (int k = 0; k < 2; ++k) dst[n][k] = *(const PG8_LAS bf16x8*)(lds + PG8_SB(b, h) + boff + n * 2048 + k * 1024); } while (0)
#define PG8_MMA(ai, bj, At, Bt) do { __builtin_amdgcn_s_setprio(1); _Pragma("unroll") for (int m = 0; m < 4; ++m) _Pragma("unroll") for (int n = 0; n < 2; ++n) _Pragma("unroll") for (int k = 0; k < 2; ++k) \
        acc[ai][bj][m][n] = __builtin_amdgcn_mfma_f32_16x16x32_bf16(Bt[n][k], At[m][k], acc[ai][bj][m][n], 0, 0, 0); __builtin_amdgcn_s_setprio(0); } while (0)
#define PG8_WAIT_V(n) asm volatile("s_waitcnt vmcnt(" #n ")" ::: "memory")
#define PG8_WAIT_L(n) asm volatile("s_waitcnt lgkmcnt(" #n ")" ::: "memory")
#define PG8_BAR __builtin_amdgcn_s_barrier()
#define PG8_SCHED __builtin_amdgcn_sched_barrier(0)
    Unit cur, nxt; int ui = 0;
    if (!S.next(0, cur)) return;
    f32x4 acc[2][2][4][2];
#pragma unroll
    for (int a = 0; a < 2; ++a)
#pragma unroll
        for (int b = 0; b < 2; ++b)
#pragma unroll
            for (int m = 0; m < 4; ++m)
#pragma unroll
                for (int n = 0; n < 2; ++n) acc[a][b][m][n] = (f32x4){0.f, 0.f, 0.f, 0.f};
    bf16x8 At[4][2], B0[2][2], B1[2][2];
    const char* cA = (const char*)g.A + (size_t)cur.pm * tstepA; const char* cB = (const char*)g.Bt + (size_t)cur.pn * tstep;
    S.a_ready(cur);
    if constexpr (SP2) {
        PG8_STAGE(PG8_SB(0, 0), cB, voffB); PG8_STAGE(PG8_SB(0, 1), cB + hstep, voffB); PG8_STAGE(PG8_SA(0, 0), cA, voffA); PG8_STAGE(PG8_SA(0, 1), cA + hstepA, voffA);
        if (wr == 1) PG8_BAR;
        PG8_WAIT_V(2); PG8_BAR;
        PG8_STAGE(PG8_SB(1, 0), cB + kstep, voffB); PG8_STAGE(PG8_SA(1, 0), cA + kstep, voffA); PG8_STAGE(PG8_SB(1, 1), cB + hstep + kstep, voffB);
        PG8_WAIT_V(6); PG8_BAR;
    } else {
        PG8_STAGE(PG8_SB(0, 0), cB, voffB); PG8_STAGE(PG8_SA(0, 0), cA, voffA); PG8_STAGE(PG8_SB(0, 1), cB + hstep, voffB); PG8_STAGE(PG8_SA(0, 1), cA + hstepA, voffA);
        if (wr == 1) PG8_BAR;
        PG8_WAIT_V(4); PG8_BAR;
        PG8_STAGE(PG8_SB(1, 0), cB + kstep, voffB); PG8_STAGE(PG8_SA(1, 0), cA + kstep, voffA); PG8_STAGE(PG8_SB(1, 1), cB + hstep + kstep, voffB);
        PG8_WAIT_V(6); PG8_BAR;
    }
    for (;;) {
        const bool has_next = S.next(ui + 1, nxt);
        const char* nA = has_next ? (const char*)g.A + (size_t)nxt.pm * tstepA : cA; const char* nB = has_next ? (const char*)g.Bt + (size_t)nxt.pn * tstep : cB;
        for (int t = 0; t < nt; t += 2) {
            const bool last = (t == nt - 2);
            const char* a1 = cA + (size_t)(t + 1) * kstep;
            const char* a2 = last ? nA : cA + (size_t)(t + 2) * kstep; const char* b2 = last ? nB : cB + (size_t)(t + 2) * kstep;
            const char* a3 = a2 + kstep; const char* b3 = b2 + kstep;
            if (last && has_next) S.a_ready(nxt);
            if constexpr (SP2) {
            PG8_LDB(B0, 0, 0); PG8_LDB(B1, 0, 1); PG8_SCHED; PG8_LDA(At, 0, 0); PG8_STAGE(PG8_SA(1, 1), a1 + hstepA, voffA);
            PG8_WAIT_V(8); PG8_WAIT_L(0); PG8_BAR; PG8_MMA(0, 0, At, B0); PG8_MMA(0, 1, At, B1); PG8_BAR; PG8_SCHED;
            PG8_LDA(At, 0, 1); PG8_STAGE(PG8_SB(0, 0), b2, voffB); PG8_STAGE(PG8_SB(0, 1), b2 + hstep, voffB); PG8_STAGE(PG8_SA(0, 0), a2, voffA);
            PG8_WAIT_V(8); PG8_WAIT_L(0); PG8_BAR; PG8_MMA(1, 0, At, B0); PG8_MMA(1, 1, At, B1); PG8_BAR; PG8_SCHED;
            PG8_LDB(B0, 1, 0); PG8_LDB(B1, 1, 1); PG8_SCHED; PG8_LDA(At, 1, 0); PG8_STAGE(PG8_SA(0, 1), a2 + hstepA, voffA);
            PG8_WAIT_V(8); PG8_WAIT_L(0); PG8_BAR; PG8_MMA(0, 0, At, B0); PG8_MMA(0, 1, At, B1); PG8_BAR; PG8_SCHED;
            PG8_LDA(At, 1, 1); PG8_STAGE(PG8_SB(1, 0), b3, voffB); PG8_STAGE(PG8_SB(1, 1), b3 + hstep, voffB); PG8_STAGE(PG8_SA(1, 0), a3, voffA);
            PG8_WAIT_V(8); PG8_WAIT_L(0); PG8_BAR; PG8_MMA(1, 0, At, B0); PG8_MMA(1, 1, At, B1); PG8_BAR; PG8_SCHED;
            } else {
            PG8_LDB(B0, 0, 0); PG8_SCHED; PG8_LDA(At, 0, 0); PG8_STAGE(PG8_SA(1, 1), a1 + hstepA, voffA);
            PG8_WAIT_L(8); PG8_BAR; PG8_WAIT_L(0); PG8_MMA(0, 0, At, B0); PG8_BAR; PG8_SCHED;
            PG8_LDB(B1, 0, 1); PG8_STAGE(PG8_SB(0, 0), b2, voffB);
            PG8_BAR; PG8_WAIT_L(0); PG8_MMA(0, 1, At, B1); PG8_BAR;
            PG8_LDA(At, 0, 1); PG8_STAGE(PG8_SA(0, 0), a2, voffA);
            PG8_BAR; PG8_WAIT_L(0); PG8_MMA(1, 0, At, B0); PG8_BAR; PG8_SCHED;
            PG8_STAGE(PG8_SB(0, 1), b2 + hstep, voffB);
            PG8_WAIT_V(6); PG8_BAR; PG8_MMA(1, 1, At, B1); PG8_BAR;
            PG8_LDB(B0, 1, 0); PG8_SCHED; PG8_LDA(At, 1, 0); PG8_STAGE(PG8_SA(0, 1), a2 + hstepA, voffA);
            PG8_WAIT_L(8); PG8_BAR; PG8_WAIT_L(0); PG8_MMA(0, 0, At, B0); PG8_BAR; PG8_SCHED;
            PG8_LDB(B1, 1, 1); PG8_STAGE(PG8_SB(1, 0), b3, voffB);
            PG8_BAR; PG8_WAIT_L(0); PG8_MMA(0, 1, At, B1); PG8_BAR;
            PG8_LDA(At, 1, 1); PG8_STAGE(PG8_SA(1, 0), a3, voffA);
            PG8_BAR; PG8_WAIT_L(0); PG8_MMA(1, 0, At, B0); PG8_BAR; PG8_SCHED;
            PG8_STAGE(PG8_SB(1, 1), b3 + hstep, voffB);
            PG8_WAIT_V(6); PG8_BAR; PG8_MMA(1, 1, At, B1); PG8_BAR;
            }
        }
        if constexpr (ALIGN_EPI) { if (wr == 0) PG8_BAR; }
        if constexpr (!Epi::AFTER_DRAIN) { E(acc, cur, wr, wc, fr, fq); S.done(cur); }
        if (!has_next) break;
#pragma unroll
        for (int a = 0; a < 2; ++a)
#pragma unroll
            for (int b = 0; b < 2; ++b)
#pragma unroll
                for (int m = 0; m < 4; ++m)
#pragma unroll
                    for (int n = 0; n < 2; ++n) acc[a][b][m][n] = (f32x4){0.f, 0.f, 0.f, 0.f};
        cur = nxt; cA = nA; cB = nB; ++ui;
        if constexpr (ALIGN_EPI) { if (wr == 1) PG8_BAR; }
    }
    PG8_WAIT_V(0);
    if constexpr (!ALIGN_EPI) { if (wr == 0) PG8_BAR; }
    PG8_BAR;
    if constexpr (Epi::AFTER_DRAIN) { E.fused(acc, cur, wr, wc, fr, fq, lds, wid, lane); S.done(cur); }
#undef PG8_SA
#undef PG8_SB
#undef PG8_STAGE
#undef PG8_LDA
#undef PG8_LDB
#undef PG8_MMA
#undef PG8_WAIT_V
#undef PG8_WAIT_L
#undef PG8_BAR
#undef PG8_SCHED
}
}

#define PG8_ALIGN true
#define PG8_SP2 true
namespace mk {
using pg8::f32x4; using pg8::u32x4; using pg8::Unit; using pg8::BM; using pg8::HALF;
typedef unsigned u32x2 __attribute__((ext_vector_type(2)));
__device__ __forceinline__ unsigned cvt_pk_bf16(float lo, float hi) { unsigned r; asm volatile("v_cvt_pk_bf16_f32 %0, %1, %2" : "=v"(r) : "v"(lo), "v"(hi)); return r; }
__device__ __forceinline__ float rstd16(const float* ssq, int row) { const f32x4* p = (const f32x4*)(ssq + (size_t)row * 16); const f32x4 a = p[0], b = p[1], c = p[2], d = p[3];
    return rsqrtf((((a[0] + a[1]) + (a[2] + a[3])) + ((b[0] + b[1]) + (b[2] + b[3])) + ((c[0] + c[1]) + (c[2] + c[3])) + ((d[0] + d[1]) + (d[2] + d[3]))) * (1.f / D) + EPS); }
struct EpiStoreMK { static constexpr bool PERM = true, AFTER_DRAIN = false; bf16_t* O; long long ldc;
    __device__ __forceinline__ void operator()(const f32x4 (&acc)[2][2][4][2], const Unit& u, int wr, int wc, int fr, int fq) const {
        const int row0 = u.pm * BM + wr * 64 + fr, col0 = u.pn * BM + wc * 32 + 8 * fq;
#pragma unroll
        for (int ai = 0; ai < 2; ++ai)
#pragma unroll
            for (int m = 0; m < 4; ++m) { bf16_t* rowp = O + (size_t)(row0 + ai * HALF + m * 16) * ldc + col0;
#pragma unroll
                for (int bj = 0; bj < 2; ++bj) { const f32x4 v0 = acc[ai][bj][m][0], v1 = acc[ai][bj][m][1];
                    u32x4 w; w.x = cvt_pk_bf16(v0[0], v0[1]); w.y = cvt_pk_bf16(v0[2], v0[3]); w.z = cvt_pk_bf16(v1[0], v1[1]); w.w = cvt_pk_bf16(v1[2], v1[3]);
                    *(u32x4*)(rowp + bj * HALF) = w; } }
    } };
struct EpiResidMK { static constexpr bool PERM = false, AFTER_DRAIN = false;
    const float* xin_lat; const float* xin_ctx; float* xout_lat; float* xout_ctx; const float* gate; const float* scale_next; bf16_t* An; float* ssq;
    __device__ __forceinline__ void operator()(const f32x4 (&acc)[2][2][4][2], const Unit& u, int wr, int wc, int fr, int fq) const {
        const int rowt = u.pm * BM; const bool lat = rowt < LAT; const int r = lat ? (rowt >> 11) : 8;
        const float* xin = lat ? xin_lat + (size_t)rowt * D : xin_ctx + (size_t)(rowt - LAT) * D; float* xout = lat ? xout_lat + (size_t)rowt * D : xout_ctx + (size_t)(rowt - LAT) * D;
        const int colb = u.pn * BM + wc * 32 + 4 * fq;
        float q[2][4];
#pragma unroll
        for (int ai = 0; ai < 2; ++ai)
#pragma unroll
            for (int m = 0; m < 4; ++m) q[ai][m] = 0.f;
#pragma unroll
        for (int bj = 0; bj < 2; ++bj)
#pragma unroll
            for (int n = 0; n < 2; ++n) { const int col = colb + bj * HALF + n * 16;
                const f32x4 gv = *(const f32x4*)(gate + (size_t)r * 6144 + col);
                const f32x4 sv = scale_next ? *(const f32x4*)(scale_next + (size_t)r * 6144 + col) + 1.0f : (f32x4){1.f, 1.f, 1.f, 1.f};
#pragma unroll
                for (int ai = 0; ai < 2; ++ai)
#pragma unroll
                    for (int m = 0; m < 4; ++m) { const size_t off = (size_t)(ai * HALF + wr * 64 + m * 16 + fr) * D + col;
                        const f32x4 xn = *(const f32x4*)(xin + off) + gv * acc[ai][bj][m][n];
                        *(f32x4*)(xout + off) = xn; q[ai][m] += (xn[0] * xn[0] + xn[1] * xn[1]) + (xn[2] * xn[2] + xn[3] * xn[3]);
                        if (An) { const f32x4 a = xn * sv; u32x2 w; w.x = cvt_pk_bf16(a[0], a[1]); w.y = cvt_pk_bf16(a[2], a[3]); *(u32x2*)(An + (size_t)rowt * D + off) = w; } }
                asm volatile("" ::: "memory"); }
        if (ssq) {
#pragma unroll
            for (int ai = 0; ai < 2; ++ai)
#pragma unroll
                for (int m = 0; m < 4; ++m) { float t = q[ai][m]; t += __shfl_xor(t, 16); t += __shfl_xor(t, 32);
                    if (fq == 0) ssq[(size_t)(rowt + ai * HALF + wr * 64 + m * 16 + fr) * 16 + u.pn * 4 + wc] = t; } }
    } };
__device__ __forceinline__ float fast_sigmoid(float x) { return __builtin_amdgcn_rcpf(1.f + __builtin_amdgcn_exp2f(-1.4426950408889634f * x)); }
struct EpiIn1MK { static constexpr bool PERM = true, AFTER_DRAIN = false;
    const float* ssq; const float* bias; const float* lbv; bf16_t* Q; bf16_t* GG; bf16_t* V; f16_t* LF; f16_t* LB;
    template <int KIND>
    __device__ __forceinline__ void body(const f32x4 (&acc)[2][2][4][2], unsigned short* dst, const float* lbp, int rowt, int r, int colb, int chb, int wr, int fr) const {
#pragma unroll
        for (int bj = 0; bj < 2; ++bj) {
            f32x4 bv[2], lbw[2];
#pragma unroll
            for (int n = 0; n < 2; ++n) { bv[n] = *(const f32x4*)(bias + (size_t)r * HGN + colb + bj * HALF + 4 * n);
                lbw[n] = KIND == 2 ? *(const f32x4*)(lbp + chb + bj * HALF + 4 * n) : (f32x4){0.f, 0.f, 0.f, 0.f}; }
#pragma unroll
            for (int ai = 0; ai < 2; ++ai)
#pragma unroll
                for (int m = 0; m < 4; ++m) { const int row = rowt + ai * HALF + wr * 64 + m * 16 + fr; float v[8]; const float rsv = rstd16(ssq, row);
#pragma unroll
                    for (int n = 0; n < 2; ++n)
#pragma unroll
                        for (int e = 0; e < 4; ++e) { float val = rsv * acc[ai][bj][m][n][e] + bv[n][e];
                            if (KIND == 0) val = val * fast_sigmoid(val);
                            else if (KIND == 2) { const float lb = lbw[n][e]; val = 0.6931471805599453f * __builtin_amdgcn_logf(lb + (1.f - lb) * fast_sigmoid(val)); }
                            v[n * 4 + e] = val; }
                    u32x4 w;
                    if (KIND == 2) { typedef _Float16 h2 __attribute__((ext_vector_type(2)));
                        h2 a = {(_Float16)v[0], (_Float16)v[1]}, b = {(_Float16)v[2], (_Float16)v[3]}, c = {(_Float16)v[4], (_Float16)v[5]}, d = {(_Float16)v[6], (_Float16)v[7]};
                        w.x = __builtin_bit_cast(unsigned, a); w.y = __builtin_bit_cast(unsigned, b); w.z = __builtin_bit_cast(unsigned, c); w.w = __builtin_bit_cast(unsigned, d); }
                    else { w.x = cvt_pk_bf16(v[0], v[1]); w.y = cvt_pk_bf16(v[2], v[3]); w.z = cvt_pk_bf16(v[4], v[5]); w.w = cvt_pk_bf16(v[6], v[7]); }
                    *(u32x4*)(dst + (size_t)row * D + chb + bj * HALF) = w; }
            asm volatile("" ::: "memory"); }
    }
    __device__ __forceinline__ void operator()(const f32x4 (&acc)[2][2][4][2], const Unit& u, int wr, int wc, int fr, int fq) const {
        const int rowt = u.pm * BM; const int r = rowt < LAT ? (rowt >> 11) : 8; const int blk = u.pn >> 2;
        const int colb = u.pn * BM + wc * 32 + 8 * fq, chb = (u.pn & 3) * BM + wc * 32 + 8 * fq;
        if (blk == 0) body<0>(acc, Q, lbv, rowt, r, colb, chb, wr, fr);
        else if (blk == 4) body<0>(acc, GG, lbv, rowt, r, colb, chb, wr, fr);
        else if (blk == 1) body<1>(acc, V, lbv, rowt, r, colb, chb, wr, fr);
        else if (blk == 2) body<2>(acc, (unsigned short*)LF, lbv, rowt, r, colb, chb, wr, fr);
        else body<2>(acc, (unsigned short*)LB, lbv + 1024, rowt, r, colb, chb, wr, fr);
    } };
struct EpiUpConvMK { static constexpr bool PERM = false, AFTER_DRAIN = false;
    const float* ssq; const float* bias; const float* cw; const float* cb; bf16_t* G; long long nrows;
    __device__ __forceinline__ static f32x4 dpp4(const f32x4 v, bool shr) { f32x4 r;
#pragma unroll
        for (int e = 0; e < 4; ++e) r[e] = shr ? __int_as_float(__builtin_amdgcn_update_dpp(0, __float_as_int(v[e]), 0x111, 0xf, 0xf, true)) : __int_as_float(__builtin_amdgcn_update_dpp(0, __float_as_int(v[e]), 0x101, 0xf, 0xf, true));
        return r; }
    __device__ __forceinline__ void conv_block(f32x4 (&o)[4], const f32x4 (&acc)[2][2][4][2], int ai, int bj, int n, const float* wp, const float* bp0, const float (&rs)[4], const int (&rr)[4], const bool (&first)[4], const bool (&last)[4], int colv) const {
        f32x4 uu[4];
#pragma unroll
        for (int m = 0; m < 4; ++m) uu[m] = rs[m] * acc[ai][bj][m][n] + *(const f32x4*)(bias + (size_t)rr[m] * FF2 + colv + bj * HALF);
        const f32x4 w0 = *(const f32x4*)(wp), w1 = *(const f32x4*)(wp + FF2), w2 = *(const f32x4*)(wp + 2 * FF2), bb = *(const f32x4*)(bp0);
        const f32x4 pp = dpp4(uu[3], true), nn = dpp4(uu[0], false); const f32x4 z = {0.f, 0.f, 0.f, 0.f};
#pragma unroll
        for (int m = 0; m < 4; ++m) { const f32x4 vp = first[m] ? z : (m == 0 ? pp : uu[m == 0 ? 0 : m - 1]), vn = last[m] ? z : (m == 3 ? nn : uu[m == 3 ? 3 : m + 1]);
            o[m] = vp * w0 + (uu[m] * w1 + (vn * w2 + bb)); }
    }
    __device__ __forceinline__ void operator()(const f32x4 (&acc)[2][2][4][2], const Unit& u, int wr, int wc, int fr, int fq) const {
        const int nr = (int)nrows;
#pragma unroll
        for (int ai = 0; ai < 2; ++ai) {
            const int tok0 = 62 * (4 * u.pm + 2 * ai + wr) - 1 + 4 * fr;
            float rs[4]; int rr[4]; bool first[4], last[4];
#pragma unroll
            for (int m = 0; m < 4; ++m) { const int tok = tok0 + m; int tc = tok < 0 ? 0 : tok; tc = tc > ROWS - 1 ? ROWS - 1 : tc; rs[m] = rstd16(ssq, tc); rr[m] = mod_row(tc);
                const int sp = tok < LAT ? (tok & 2047) : (tok & 255); first[m] = sp == 0; last[m] = sp == (tok < LAT ? 2047 : 255); }
#pragma unroll
            for (int n = 0; n < 2; ++n) {
                const int ch0 = u.pn * 128 + wc * 32 + n * 16 + 4 * fq, colv = u.pn * BM + wc * 32 + n * 16 + 4 * fq;
                f32x4 sg[4], av[4];
                conv_block(sg, acc, ai, 1, n, cw + FF + ch0, cb + FF + ch0, rs, rr, first, last, colv);
#pragma unroll
                for (int m = 0; m < 4; ++m)
#pragma unroll
                    for (int e = 0; e < 4; ++e) sg[m][e] = sg[m][e] * fast_sigmoid(sg[m][e]);
                asm volatile("" : "+v"(sg[0]), "+v"(sg[1]), "+v"(sg[2]), "+v"(sg[3]));
                conv_block(av, acc, ai, 0, n, cw + ch0, cb + ch0, rs, rr, first, last, colv);
#pragma unroll
                for (int m = 0; m < 4; ++m) { const int tok = tok0 + m, i = 4 * fr + m; const f32x4 o = av[m] * sg[m];
                    if (i >= 1 && i <= 62 && tok < nr) { u32x2 w; w.x = cvt_pk_bf16(o[0], o[1]); w.y = cvt_pk_bf16(o[2], o[3]); *(u32x2*)(G + (size_t)tok * FF + ch0) = w; } }
                asm volatile("" ::: "memory");
            }
        }
    } };
struct OrderIn1 { pg8::StaticOrder lat; int G, c;
    __device__ void init(int G_, int c_) { lat.init(LAT, HGN, G_, c_); G = G_; c = c_; }
    __device__ bool next(int i, Unit& u) const { if (lat.next(i, u)) return true; const long L = (long)i * G + c - lat.nwg; if (L < 0 || L >= 96) return false; u.pm = 64 + (int)(L / 12); u.pn = 4 + (int)(L % 12); return true; }
    __device__ __forceinline__ void a_ready(const Unit&) const {}
    __device__ __forceinline__ void done(const Unit&) const {} };
}

__device__ __forceinline__ void ph_rope(Frame& F) {
    for (int idx = F.gt; idx < ROWS * 512; idx += F.NGT) { const int row = idx >> 9, pi = idx & 511;
        const int col = (pi >> 4) * 32 + (pi & 15); const int axis = (col >> 5) & 1, f = col & 15;
        bf16_t* p = F.P0() + (size_t)row * EVN + col;
        float x1 = bf2f(p[0]), x2 = bf2f(p[16]);
        if (row < LAT) { const int t = row & 2047; const int pos = axis == 0 ? (t >> 6) : (t & 63); const float c = F.rope()[pos * 16 + f], s = F.rope()[1024 + pos * 16 + f];
            const float o1 = x1 * c - x2 * s, o2 = x2 * c + x1 * s; x1 = o1; x2 = o2; }
        if (col < 512) { x1 *= QSCALE; x2 *= QSCALE; }
        p[0] = f2bf(x1); p[16] = f2bf(x2); }
}
__device__ __forceinline__ void ph_attn_naive(Frame& F) {
    const bf16_t* P = F.P0();
    for (int it = F.gw; it < (ROWS / 64) * 8; it += F.NGW) {
        const int qb = __builtin_amdgcn_readfirstlane(it >> 3), hm = __builtin_amdgcn_readfirstlane(it & 7), h = hm >> 1, m = hm & 1; const int row = qb * 64 + F.lane;
        const bool lat = (qb * 64) < LAT; const int b = lat ? (qb * 64) >> 11 : (qb * 64 - LAT) >> 8;
        float q[64]; { const bf16_t* qp = P + (size_t)row * EVN + h * 128 + m * 64;
#pragma unroll
            for (int d = 0; d < 64; ++d) q[d] = bf2f(qp[d]); }
        float o[128];
#pragma unroll
        for (int d = 0; d < 128; ++d) o[d] = 0.f;
        float mx = -1e30f, l = 0.f; const int nkeys = lat ? 2304 : 256;
        for (int j = 0; j < nkeys; ++j) {
            const int krow = j < 256 ? LAT + b * 256 + j : b * 2048 + (j - 256);
            const bf16_t* kp = P + (size_t)krow * EVN + 512 + h * 128 + m * 64; const bf16_t* vp = P + (size_t)krow * EVN + 1024 + h * 128;
            float s = 0.f;
#pragma unroll
            for (int d = 0; d < 64; ++d) s += q[d] * bf2f(kp[d]);
            const float mn = fmaxf(mx, s), alpha = exp2f(mx - mn), p = exp2f(s - mn); l = l * alpha + p; mx = mn;
#pragma unroll
            for (int d = 0; d < 128; ++d) o[d] = o[d] * alpha + p * bf2f(vp[d]);
        }
        const float il = 1.f / l; bf16_t* op = F.ON() + (((size_t)row * 4 + h) * 2 + m) * 128;
#pragma unroll
        for (int d = 0; d < 128; ++d) op[d] = f2bf(o[d] * il);
    }
}
__device__ __forceinline__ void ph_readout0(Frame& F) {
    const float lam = F.misc()[0];
    for (int w = F.gw; w < ROWS * 4; w += F.NGW) { const int row = w >> 2, h = w & 3, lane = F.lane;
        const bf16_t* p = F.ON() + ((size_t)row * 4 + h) * 256;
        const float a = bf2f(p[lane]) - lam * bf2f(p[128 + lane]), b = bf2f(p[64 + lane]) - lam * bf2f(p[192 + lane]);
        const float rstd = rsqrtf(wave_sum(a * a + b * b) * (1.f / 128.f) + EPS);
        F.A1()[(size_t)row * D + h * 128 + lane] = f2bf(a * rstd * F.misc()[64 + h * 128 + lane]);
        F.A1()[(size_t)row * D + h * 128 + 64 + lane] = f2bf(b * rstd * F.misc()[64 + h * 128 + 64 + lane]); }
}
__device__ __forceinline__ void ph_pool_d(Frame& F) {
    const bf16_t* P = F.P0();
    for (int idx = F.gt; idx < ROWS * 512; idx += F.NGT) { const int row = idx >> 9, c = idx & 511, g = c >> 7, w = 2 << g;
        const int T = row < LAT ? 2048 : 256, t = row < LAT ? (row & 2047) : ((row - LAT) & 255), base = row - t;
        int lo = t - w / 2; if (lo < 0) lo = 0; int hi = t + w - w / 2; if (hi > T) hi = T;
        float s = 0.f; for (int tt = lo; tt < hi; ++tt) s += bf2f(P[(size_t)(base + tt) * EVN + 1536 + c]);
        F.A1()[(size_t)row * D + 512 + c] = f2bf(s / (float)(hi - lo) - bf2f(P[(size_t)row * EVN + 1536 + c])); }
}
namespace att {
using bf16x8 = __attribute__((ext_vector_type(8))) short;
using s16x4  = __attribute__((ext_vector_type(4))) short;
using f32x16 = __attribute__((ext_vector_type(16))) float;
using u32x4  = __attribute__((ext_vector_type(4))) unsigned;
constexpr int QBLK = 32, KVBLK = 64, LDP = EVN;
constexpr int SHM_V = 16384, SHM_K = 8192, L_V = 0, L_K = 2 * SHM_V, L_WS = L_K + 2 * SHM_K, L_ST = L_WS + 2048, L_END = L_ST + 8 * 8192;
constexpr float THR2 = 8.f;
#define KSWZ64(row, colB) ((row) * 128 + ((colB) ^ (((row) & 7) << 4)))
#define ASBAR() __builtin_amdgcn_sched_barrier(0)
__device__ __forceinline__ int crow(int r, int hi) { return (r & 3) + 8 * (r >> 2) + 4 * hi; }
__device__ __forceinline__ unsigned cvtpk(float lo, float hi) { unsigned r; asm volatile("v_cvt_pk_bf16_f32 %0, %1, %2" : "=v"(r) : "v"(lo), "v"(hi)); return r; }
__device__ __forceinline__ void partialSM(f32x16& p0, f32x16& p1, float& m_reg, float& mn, float& alpha) {
  float pmax = p0[0];
#pragma unroll
  for (int r = 1; r < 16; ++r) pmax = fmaxf(pmax, p0[r]);
#pragma unroll
  for (int r = 0; r < 16; ++r) pmax = fmaxf(pmax, p1[r]);
  { auto rr = __builtin_amdgcn_permlane32_swap(__float_as_uint(pmax), __float_as_uint(pmax), false, false); pmax = fmaxf(__uint_as_float(rr[0]), __uint_as_float(rr[1])); }
  if (__builtin_expect(__all(pmax - m_reg <= THR2), 1)) { mn = m_reg; alpha = 1.f; }
  else { mn = fmaxf(m_reg, pmax); alpha = __builtin_amdgcn_exp2f(m_reg - mn); m_reg = mn; }
#pragma unroll
  for (int r = 0; r < 16; ++r) p0[r] -= mn;
#pragma unroll
  for (int r = 0; r < 16; ++r) p1[r] -= mn;
#pragma unroll
  for (int r = 0; r < 16; ++r) p0[r] = __builtin_amdgcn_exp2f(p0[r]);
}
__device__ __forceinline__ void finishSM(f32x16& p0, f32x16& p1, float alpha, float& l_reg, bf16x8& pa0, bf16x8& pa1, bf16x8& pa2, bf16x8& pa3) {
#pragma unroll
  for (int r = 0; r < 16; ++r) p1[r] = __builtin_amdgcn_exp2f(p1[r]);
  float ps = 0;
#pragma unroll
  for (int r = 0; r < 16; ++r) ps += p0[r];
#pragma unroll
  for (int r = 0; r < 16; ++r) ps += p1[r];
  { auto rr = __builtin_amdgcn_permlane32_swap(__float_as_uint(ps), __float_as_uint(ps), false, false); ps = __uint_as_float(rr[0]) + __uint_as_float(rr[1]); }
  l_reg = l_reg * alpha + ps;
#define PK4(P, BASE, OUT) do { unsigned a0 = cvtpk(P[BASE + 0], P[BASE + 1]), a1 = cvtpk(P[BASE + 2], P[BASE + 3]);   \
    unsigned b0 = cvtpk(P[BASE + 4], P[BASE + 5]), b1 = cvtpk(P[BASE + 6], P[BASE + 7]);                              \
    auto r0 = __builtin_amdgcn_permlane32_swap(a0, b0, false, false); auto r1 = __builtin_amdgcn_permlane32_swap(a1, b1, false, false); \
    u32x4 w = {r0[0], r1[0], r0[1], r1[1]}; OUT = *reinterpret_cast<bf16x8*>(&w); } while (0)
  PK4(p0, 0, pa0); PK4(p0, 8, pa1); PK4(p1, 0, pa2); PK4(p1, 8, pa3);
#undef PK4
}
__device__ __forceinline__ void qkt(f32x16& p0, f32x16& p1, const char* Ks, const bf16x8* qr, int r32, int hi) {
  p0 = f32x16{}; p1 = f32x16{};
#pragma unroll
  for (int d0 = 0; d0 < 4; ++d0) { const int cb = (d0 * 16 + hi * 8) * 2;
    const bf16x8 b0 = *reinterpret_cast<const bf16x8*>(Ks + KSWZ64(r32, cb));
    const bf16x8 b1 = *reinterpret_cast<const bf16x8*>(Ks + KSWZ64(32 + r32, cb));
    p0 = __builtin_amdgcn_mfma_f32_32x32x16_bf16(b0, qr[d0], p0, 0, 0, 0);
    p1 = __builtin_amdgcn_mfma_f32_32x32x16_bf16(b1, qr[d0], p1, 0, 0, 0); }
}
__device__ __forceinline__ int v_st(int k, int c) { const int kk = (k & ~0xC) | ((k & 4) << 1) | ((k & 8) >> 1); return ((kk >> 3) * 4 + (c >> 5)) * 512 + ((kk & 7) * 32 + (c & 31)) * 2; }
__device__ __forceinline__ int v_rd_base(int lane) { return ((lane & 3) << 3) | (((lane >> 2) & 3) << 6) | (((lane >> 4) & 1) << 5) | (((lane >> 5) & 1) << 8); }
constexpr int v_rd_off(int d0, int ks, int half) { return d0 * 512 + ks * 4096 + half * 2048; }
template <int OFF> __device__ __forceinline__ s16x4 tr_read(int vb) { s16x4 r; asm volatile("ds_read_b64_tr_b16 %0, %1 offset:%2" : "=&v"(r) : "v"(vb), "i"(OFF) : "memory"); return r; }
template <int D0> __device__ __forceinline__ void pv_one(f32x16& od, int vb, bf16x8 pa0, bf16x8 pa1, bf16x8 pa2, bf16x8 pa3) {
  const s16x4 l0 = tr_read<v_rd_off(D0, 0, 0)>(vb), h0 = tr_read<v_rd_off(D0, 0, 1)>(vb), l1 = tr_read<v_rd_off(D0, 1, 0)>(vb), h1 = tr_read<v_rd_off(D0, 1, 1)>(vb);
  const s16x4 l2 = tr_read<v_rd_off(D0, 2, 0)>(vb), h2 = tr_read<v_rd_off(D0, 2, 1)>(vb), l3 = tr_read<v_rd_off(D0, 3, 0)>(vb), h3 = tr_read<v_rd_off(D0, 3, 1)>(vb);
  asm volatile("s_waitcnt lgkmcnt(0)" ::: "memory"); ASBAR();
#define PK(L, H) (bf16x8){L[0], L[1], L[2], L[3], H[0], H[1], H[2], H[3]}
  od = __builtin_amdgcn_mfma_f32_32x32x16_bf16(pa0, PK(l0, h0), od, 0, 0, 0);
  od = __builtin_amdgcn_mfma_f32_32x32x16_bf16(pa1, PK(l1, h1), od, 0, 0, 0);
  od = __builtin_amdgcn_mfma_f32_32x32x16_bf16(pa2, PK(l2, h2), od, 0, 0, 0);
  od = __builtin_amdgcn_mfma_f32_32x32x16_bf16(pa3, PK(l3, h3), od, 0, 0, 0);
#undef PK
}
__device__ __forceinline__ void pv_d0(f32x16* o, int vb, bf16x8 pa0, bf16x8 pa1, bf16x8 pa2, bf16x8 pa3) {
  pv_one<0>(o[0], vb, pa0, pa1, pa2, pa3); pv_one<1>(o[1], vb, pa0, pa1, pa2, pa3); pv_one<2>(o[2], vb, pa0, pa1, pa2, pa3); pv_one<3>(o[3], vb, pa0, pa1, pa2, pa3);
}
struct KeyRows { int ctx0, lat0; bool isctx; __device__ __forceinline__ int operator()(int t) const { return (isctx || t < 4) ? ctx0 + 64 * t : lat0 + 64 * (t - 4); } };
__device__ __forceinline__ void attn_map(const bf16_t* __restrict__ Pq, const bf16_t* __restrict__ Pk, const bf16_t* __restrict__ Pv, const KeyRows kr, int NT, char* lds, f32x16 (&o)[4], float& l_out) {
  int tid_ = threadIdx.x; asm volatile("" : "+v"(tid_));
  const int tid = tid_, wid = tid >> 6, lane = tid & 63, r32 = lane & 31, hi = lane >> 5;
  char* V_lds = lds + L_V; char* K_lds = lds + L_K;
  float* wsf = (float*)(lds + L_WS) + wid * 64; float* al_l = wsf + 32;
  float m_reg = -1e30f, l_reg = 0; bf16x8 qr[4];
#pragma unroll
  for (int d = 0; d < 4; ++d) o[d] = f32x16{};
  const bf16_t* Qw = Pq + (long)(wid * QBLK + r32) * LDP + hi * 8;
#pragma unroll
  for (int d0 = 0; d0 < 4; ++d0) qr[d0] = *reinterpret_cast<const bf16x8*>(Qw + d0 * 16);
  const int sr = tid >> 4, sc = (tid & 15) * 8, vst0 = v_st(sr, sc), vst1 = v_st(32 + sr, sc);
  const int kr_ = tid >> 3, kc = (tid & 7) * 8, kst = KSWZ64(kr_, kc * 2);
  const int vb0 = (int)(uintptr_t)V_lds + v_rd_base(lane);
  struct { bf16x8 vs0, vs1, ks0; } sr_[1];
#define SLOAD(i, t) do { const long k0_ = kr(t); sr_[i].vs0 = *reinterpret_cast<const bf16x8*>(&Pv[(k0_ + sr) * LDP + sc]); sr_[i].vs1 = *reinterpret_cast<const bf16x8*>(&Pv[(k0_ + 32 + sr) * LDP + sc]); \
    sr_[i].ks0 = *reinterpret_cast<const bf16x8*>(&Pk[(k0_ + kr_) * LDP + kc]); } while (0)
#define SWRITE(b, i) do { *(bf16x8*)(V_lds + (b) * SHM_V + vst0) = sr_[i].vs0; *(bf16x8*)(V_lds + (b) * SHM_V + vst1) = sr_[i].vs1; *(bf16x8*)(K_lds + (b) * SHM_K + kst) = sr_[i].ks0; } while (0)
#define SWAIT() asm volatile("s_waitcnt vmcnt(0)" ::: "memory")
#define RESC(a) do { if (__any((a) < 1.f)) { if (hi == 0) al_l[r32] = (a); asm volatile("s_waitcnt lgkmcnt(0)" ::: "memory"); \
    _Pragma("unroll") for (int d = 0; d < 4; ++d) _Pragma("unroll") for (int r = 0; r < 16; ++r) o[d][r] *= al_l[crow(r, hi)]; } } while (0)
  f32x16 pA0, pA1, pB0, pB1; float mnA, mnB, alA, alB; bf16x8 pa0, pa1, pa2, pa3;
  constexpr int SE = 0, SO = 0;
  SLOAD(SE, 0); asm volatile("s_waitcnt vmcnt(0)" ::: "memory"); SWRITE(0, SE); __syncthreads();
  qkt(pA0, pA1, K_lds, qr, r32, hi); partialSM(pA0, pA1, m_reg, mnA, alA);
  SLOAD(SO, 1);
  SWAIT(); SWRITE(1, SO); __syncthreads();
  for (int j = 1; j + 1 < NT; j += 2) {
    ASBAR(); qkt(pB0, pB1, K_lds + SHM_K, qr, r32, hi);
    finishSM(pA0, pA1, alA, l_reg, pa0, pa1, pa2, pa3); ASBAR();
    SLOAD(SO, j + 1); ASBAR();
    pv_d0(o, vb0, pa0, pa1, pa2, pa3); partialSM(pB0, pB1, m_reg, mnB, alB);
    __syncthreads(); SWAIT(); SWRITE(0, SE);
    RESC(alB); __syncthreads();
    ASBAR(); qkt(pA0, pA1, K_lds, qr, r32, hi);
    finishSM(pB0, pB1, alB, l_reg, pa0, pa1, pa2, pa3); ASBAR();
    SLOAD(SE, j + 2); ASBAR();
    pv_d0(o, vb0 + SHM_V, pa0, pa1, pa2, pa3); partialSM(pA0, pA1, m_reg, mnA, alA);
    __syncthreads(); SWAIT(); SWRITE(1, SO);
    RESC(alA); __syncthreads();
  }
  ASBAR(); qkt(pB0, pB1, K_lds + SHM_K, qr, r32, hi);
  finishSM(pA0, pA1, alA, l_reg, pa0, pa1, pa2, pa3); ASBAR();
  pv_d0(o, vb0, pa0, pa1, pa2, pa3); partialSM(pB0, pB1, m_reg, mnB, alB);
  __syncthreads(); RESC(alB);
  finishSM(pB0, pB1, alB, l_reg, pa0, pa1, pa2, pa3); ASBAR();
  pv_d0(o, vb0 + SHM_V, pa0, pa1, pa2, pa3);
  l_out = l_reg;
#undef SLOAD
#undef SWRITE
#undef SWAIT
#undef RESC
}
__device__ __forceinline__ void attn_unit(const bf16_t* P0, int qrow0, int h, int ctx0, int lat0, bool isctx, float lam, const float* gain, bf16_t* A1, char* lds) {
  int tid_ = threadIdx.x; asm volatile("" : "+v"(tid_));
  const int tid = tid_, wid = tid >> 6, lane = tid & 63, r32 = lane & 31, hi = lane >> 5;
  float* wsf = (float*)(lds + L_WS) + wid * 64;
  bf16_t* stash = (bf16_t*)(lds + L_ST + wid * 8192);
  const KeyRows kr{ctx0, lat0, isctx}; const int NT = isctx ? 4 : 36;
  f32x16 o[4]; float l_reg;
  attn_map(P0 + (long)qrow0 * LDP + h * 128, P0 + 512 + h * 128, P0 + 1024 + h * 128, kr, NT, lds, o, l_reg);
  if (hi == 0) wsf[r32] = l_reg; asm volatile("s_waitcnt lgkmcnt(0)" ::: "memory");
#pragma unroll
  for (int r = 0; r < 16; ++r) { const float rl = __builtin_amdgcn_rcpf(wsf[crow(r, hi)]);
#pragma unroll
    for (int d0 = 0; d0 < 4; ++d0) stash[crow(r, hi) * 128 + d0 * 32 + r32] = f2bf(o[d0][r] * rl); }
  asm volatile("s_waitcnt lgkmcnt(0)" ::: "memory");
  __syncthreads();
  attn_map(P0 + (long)qrow0 * LDP + h * 128 + 64, P0 + 512 + h * 128 + 64, P0 + 1024 + h * 128, kr, NT, lds, o, l_reg);
  if (hi == 0) wsf[r32] = l_reg; asm volatile("s_waitcnt lgkmcnt(0)" ::: "memory");
  float ss[16];
#pragma unroll
  for (int r = 0; r < 16; ++r) { const float rl = lam * __builtin_amdgcn_rcpf(wsf[crow(r, hi)]); float t = 0.f;
#pragma unroll
    for (int d0 = 0; d0 < 4; ++d0) { const float v = bf2f(stash[crow(r, hi) * 128 + d0 * 32 + r32]) - o[d0][r] * rl; o[d0][r] = v; t += v * v; }
#pragma unroll
    for (int off = 1; off < 32; off <<= 1) t += __shfl_xor(t, off);
    ss[r] = rsqrtf(t * (1.f / 128.f) + EPS); }
#pragma unroll
  for (int d0 = 0; d0 < 4; ++d0) { const float g = gain[h * 128 + d0 * 32 + r32];
#pragma unroll
    for (int r = 0; r < 16; ++r) stash[crow(r, hi) * 128 + d0 * 32 + r32] = f2bf(o[d0][r] * ss[r] * g); }
  asm volatile("s_waitcnt lgkmcnt(0)" ::: "memory");
  bf16_t* Ow = A1 + (long)(qrow0 + wid * QBLK) * D + h * 128;
#pragma unroll
  for (int i = 0; i < 8; ++i) { const int row = i * 4 + (lane >> 4), ch = lane & 15; const u32x4 v = *(const u32x4*)(stash + row * 128 + ch * 8); *(u32x4*)(Ow + (long)row * D + ch * 8) = v; }
  asm volatile("s_waitcnt lgkmcnt(0)" ::: "memory");
  __syncthreads();
}
#undef KSWZ64
#undef ASBAR
}
__device__ __forceinline__ void ph_attn_mk(Frame& F) {
    const float lam = F.misc()[0]; const float* gain = F.misc() + 64;
    for (int u = blockIdx.x; u < 288; u += gridDim.x) {
        if (u < 256) { const int bh = u & 31, qb = u >> 5, b = bh >> 2, h = bh & 3; att::attn_unit(F.P0(), b * 2048 + qb * 256, h, LAT + b * 256, b * 2048, false, lam, gain, F.A1(), (char*)F.lds); }
        else { const int bh = u - 256, b = bh >> 2, h = bh & 3; att::attn_unit(F.P0(), LAT + b * 256, h, LAT + b * 256, 0, true, lam, gain, F.A1(), (char*)F.lds); }
    }
}
__device__ __forceinline__ void ph_convgate(Frame& F, int l, int rowBase, int rowBeg, int rowEnd) {
    const float* cw = F.conv_w() + (size_t)l * 3 * FF2; const float* cb = F.conv_b() + (size_t)l * FF2;
    const long n = (long)(rowEnd - rowBeg) * FF;
    for (long idx = F.gt; idx < n; idx += F.NGT) { const int row = rowBeg + (int)(idx / FF), ch = (int)(idx % FF);
        const int T = row < LAT ? 2048 : 256, t = row < LAT ? (row & 2047) : ((row - LAT) & 255);
        const int na = (ch >> 7) * 256 + (ch & 127), ng = na + 128;
        const bf16_t* u = F.UCH() + (size_t)(row - rowBase) * FF2;
        float a = bf2f(u[na]) * cw[FF2 + ch] + cb[ch], gt = bf2f(u[ng]) * cw[FF2 + FF + ch] + cb[FF + ch];
        if (t > 0) { a += bf2f(u[na - FF2]) * cw[ch]; gt += bf2f(u[ng - FF2]) * cw[FF + ch]; }
        if (t < T - 1) { a += bf2f(u[na + FF2]) * cw[2 * FF2 + ch]; gt += bf2f(u[ng + FF2]) * cw[2 * FF2 + FF + ch]; }
        F.G()[(size_t)row * FF + ch] = f2bf(a * silu_f(gt)); }
}
__device__ __forceinline__ void ph_scan_naive(Frame& F, int dir) {
    if ((int)blockIdx.x * 4 >= 64) return;
    const int vb = blockIdx.x * 4 + (F.tid >> 7), d = F.tid & 127;
    LAS float* qs = (LAS float*)(F.lds + (F.tid >> 7) * 1536); LAS float* fs = qs + 128; LAS float* ks = qs + 256;
    const int b = vb >> 3, h = vb & 7;
    float S[128];
#pragma unroll
    for (int c = 0; c < 128; ++c) S[c] = 0.f;
    const f16_t* L = dir ? F.LB1() : F.LF1();
    for (int step = 0; step < 2304; ++step) {
        const bool isctx = step < 256; const int t = isctx ? (dir ? 255 - step : step) : (dir ? 2047 - (step - 256) : (step - 256));
        const int row = isctx ? LAT + b * 256 + t : b * 2048 + t; const size_t o = (size_t)row * D + h * 128;
        const float f = expf((float)L[o + d]); fs[d] = f; ks[d] = 1.f - f; qs[d] = isctx ? 0.f : bf2f(F.Q1()[o + d]);
        const float v = bf2f(F.V1()[o + d]);
        __syncthreads();
        float acc = 0.f;
#pragma unroll
        for (int c = 0; c < 128; ++c) { S[c] = fs[c] * S[c] + ks[c] * v; acc += qs[c] * S[c]; }
        if (!isctx) { if (dir) acc += bf2f(F.OSUM()[o + d]); F.OSUM()[o + d] = f2bf(acc); }
        __syncthreads();
    }
}
__device__ __forceinline__ void ph_combine1(Frame& F) {
    for (int w = F.gw; w < LAT * 8; w += F.NGW) { const int row = w >> 3, h = w & 7, lane = F.lane; const size_t o = (size_t)row * D + h * 128;
        const float a = bf2f(F.OSUM()[o + lane]), b = bf2f(F.OSUM()[o + 64 + lane]);
        const float rstd = rsqrtf(wave_sum(a * a + b * b) * (1.f / 128.f) + EPS);
        F.A3()[o + lane] = f2bf(a * rstd * F.hg_norm()[h * 128 + lane] * bf2f(F.GG1()[o + lane]));
        F.A3()[o + 64 + lane] = f2bf(b * rstd * F.hg_norm()[h * 128 + 64 + lane] * bf2f(F.GG1()[o + 64 + lane])); }
}
__device__ __forceinline__ void ph_final(Frame& F) {
    for (int row = F.gw; row < LAT; row += F.NGW) { float* xr = F.out() + (size_t)row * D;
        float4 v[4]; float s = 0.f;
#pragma unroll
        for (int j = 0; j < 4; ++j) { v[j] = *(const float4*)(xr + j * 256 + F.lane * 4); s += (v[j].x * v[j].x + v[j].y * v[j].y) + (v[j].z * v[j].z + v[j].w * v[j].w); }
        const float rstd = rsqrtf(wave_sum(s) * (1.f / D) + EPS);
#pragma unroll
        for (int j = 0; j < 4; ++j) { const float4 g = *(const float4*)(F.final_norm() + j * 256 + F.lane * 4); *(float4*)(xr + j * 256 + F.lane * 4) = make_float4(v[j].x * rstd * g.x, v[j].y * rstd * g.y, v[j].z * rstd * g.z, v[j].w * rstd * g.w); }
    }
}

constexpr int NPHASE = 14;
#ifndef OPT_P2
#define OPT_P2 1
#endif
#ifndef OPT_P4
#define OPT_P4 1
#endif
#ifndef OPT_P6
#define OPT_P6 1
#endif
#ifndef OPT_P7
#define OPT_P7 1
#endif
#ifndef OPT_P10
#define OPT_P10 1
#endif
#ifndef OPT_P5
#define OPT_P5 1
#endif
#ifndef OPT_P11
#define OPT_P11 1
#endif
#ifndef OPT_P3
#define OPT_P3 1
#endif
#ifndef OPT_P12
#define OPT_P12 1
#endif
__global__ void __launch_bounds__(NTHR, 2) mk_fwd(Args args) {
    extern __shared__ __attribute__((aligned(16))) unsigned char lds_raw[];
    Frame F(args);
    F.lds = (LAS unsigned char*)lds_raw;
    F.tid = threadIdx.x; F.lane = F.tid & 63; F.wave = __builtin_amdgcn_readfirstlane(F.tid >> 6);
    F.gw = blockIdx.x * 8 + F.wave; F.NGW = gridDim.x * 8; F.gt = blockIdx.x * NTHR + F.tid; F.NGT = gridDim.x * NTHR;
    unsigned char* ws = args.ws;

    volatile LAS unsigned* MISC = (volatile LAS unsigned*)(F.lds + LDS_MISC);
    if (F.tid < 64) MISC[F.tid] = 0u;
    __syncthreads();
    XcdBarrier bar = xcd_barrier_post((unsigned*)(ws + OFF_CTL) + 1024, MISC + 8);
#define GRID_BAR() xcd_barrier(bar)
    const int lo = args.ph_lo, hi = args.ph_hi;
#define IN(k) (lo <= (k) && (k) < hi)
#define SEAM(k) do { if (IN(k) && IN((k) + 1)) GRID_BAR(); } while (0)

    if (IN(0)) { ph_mods(F); ph_small(F); __syncthreads(); ph_transposes(F); ph_weff(F); }
    SEAM(0);
    if (IN(1)) { ph_bias(F); ph_norm_mod(F); }
    SEAM(1);
    if (IN(2)) {
#if OPT_P2
        { pg8::Gemm g{F.A0(), F.Win0(), ROWS, EVN, 1024, 0}; pg8::StaticOrder S; S.init(ROWS, EVN, (int)gridDim.x, (int)blockIdx.x); mk::EpiStoreMK E{F.P0(), EVN};
          pg8::gemm_phase<mk::EpiStoreMK, pg8::StaticOrder, PG8_ALIGN, PG8_SP2>(F.lds, g, S, E); }
#else
        gemm_naive_phase(F, F.A0(), F.Win0(), EVN, 1024, 0, ROWS, EpiStore{F.P0(), EVN});
#endif
        GRID_BAR(); ph_rope(F); }
    SEAM(2);
    if (IN(3)) {
#if OPT_P3
        ph_attn_mk(F); ph_pool_d(F);
#else
        ph_attn_naive(F); ph_pool_d(F); GRID_BAR(); ph_readout0(F);
#endif
    }
    SEAM(3);
    if (IN(4)) {
#if OPT_P4
        { pg8::Gemm g{F.A1(), F.Wout0(), ROWS, 1024, 1024, 0}; pg8::StaticOrder S; S.init(ROWS, 1024, (int)gridDim.x, (int)blockIdx.x);
          mk::EpiResidMK E{F.x(), F.ctx(), F.out(), F.xc(), F.mods() + 2 * 1024, F.mods() + 4 * 1024, F.A0(), F.ssq()};
          pg8::gemm_phase<mk::EpiResidMK, pg8::StaticOrder, PG8_ALIGN, PG8_SP2>(F.lds, g, S, E); }
#else
        gemm_naive_phase(F, F.A1(), F.Wout0(), 1024, 1024, 0, ROWS, EpiResid{F.x(), F.ctx(), F.out(), F.xc(), F.mods() + 2 * 1024, F.mods() + 4 * 1024, F.A0()}); GRID_BAR(); ph_rowssq(F, ROWS);
#endif
    }
    SEAM(4);
    if (IN(5)) {
#if OPT_P5
        { pg8::Gemm g{F.A0() - 1024, F.Wup0(), ROWS, FF2, 1024, 1}; pg8::StaticOrder S; S.init2((ROWS + 247) / 248, FF2 / 256, (int)gridDim.x, (int)blockIdx.x);
          mk::EpiUpConvMK E{F.ssq(), F.bup(), F.conv_w(), F.conv_b(), F.G(), ROWS};
          pg8::gemm_phase<mk::EpiUpConvMK, pg8::StaticOrder, PG8_ALIGN, PG8_SP2>(F.lds, g, S, E); }
#else
        for (int c0 = 0; c0 < ROWS; c0 += 4608) { const int c1 = c0 + 4608, rb = c0 - 1, re = c1 + 1 > ROWS ? ROWS : c1 + 1;
            gemm_naive_phase(F, F.A0(), F.Wup0(), FF2, 1024, rb, re, EpiUp{F.UCH(), rb, F.ssq(), F.bup()}); GRID_BAR(); ph_convgate(F, 0, rb, c0, c1); if (c1 < ROWS) GRID_BAR(); }
#endif
    }
    SEAM(5);
    if (IN(6)) {
#if OPT_P6
        { pg8::Gemm g{F.G(), F.Wdn0(), ROWS, 1024, FF, 0}; pg8::StaticOrder S; S.init(ROWS, 1024, (int)gridDim.x, (int)blockIdx.x);
          mk::EpiResidMK E{F.out(), F.xc(), F.out(), F.xc(), F.mods() + 5 * 1024, F.mods() + 9 * 6144 + 1 * 1024, F.A0(), F.ssq()};
          pg8::gemm_phase<mk::EpiResidMK, pg8::StaticOrder, PG8_ALIGN, PG8_SP2>(F.lds, g, S, E); }
#else
        gemm_naive_phase(F, F.G(), F.Wdn0(), 1024, FF, 0, ROWS, EpiResid{F.out(), F.xc(), F.out(), F.xc(), F.mods() + 5 * 1024, F.mods() + 9 * 6144 + 1 * 1024, F.A0()}); GRID_BAR(); ph_rowssq(F, ROWS);
#endif
    }
    SEAM(6);
    if (IN(7)) {
#if OPT_P7
        { pg8::Gemm g{F.A0(), F.Win1(), ROWS, HGN, 1024, 0}; mk::OrderIn1 S; S.init((int)gridDim.x, (int)blockIdx.x);
          mk::EpiIn1MK E{F.ssq(), F.bin1(), F.misc() + 1024, F.Q1(), F.GG1(), F.V1(), F.LF1(), F.LB1()};
          pg8::gemm_phase<mk::EpiIn1MK, mk::OrderIn1, PG8_ALIGN, PG8_SP2>(F.lds, g, S, E); }
#else
        gemm_naive_phase(F, F.A0(), F.Win1(), HGN, 1024, 0, ROWS, EpiIn1{F.ssq(), F.bin1(), F.misc() + 1024, F.Q1(), F.GG1(), F.V1(), F.LF1(), F.LB1()});
#endif
    }
    SEAM(7);
    if (IN(8)) { ph_scan_naive(F, 0); GRID_BAR(); ph_scan_naive(F, 1); }
    SEAM(8);
    if (IN(9)) ph_combine1(F);
    SEAM(9);
    if (IN(10)) {
#if OPT_P10
        { pg8::Gemm g{F.A3(), F.Wout1(), LAT, 1024, 1024, 0}; pg8::StaticOrder S; S.init(LAT, 1024, (int)gridDim.x, (int)blockIdx.x);
          mk::EpiResidMK E{F.out(), F.xc(), F.out(), F.xc(), F.mods() + 9 * 6144 + 2 * 1024, F.mods() + 9 * 6144 + 4 * 1024, F.A0(), F.ssq()};
          pg8::gemm_phase<mk::EpiResidMK, pg8::StaticOrder, PG8_ALIGN, PG8_SP2>(F.lds, g, S, E); }
#else
        gemm_naive_phase(F, F.A3(), F.Wout1(), 1024, 1024, 0, LAT, EpiResid{F.out(), F.xc(), F.out(), F.xc(), F.mods() + 9 * 6144 + 2 * 1024, F.mods() + 9 * 6144 + 4 * 1024, F.A0()}); GRID_BAR(); ph_rowssq(F, LAT);
#endif
    }
    SEAM(10);
    if (IN(11)) {
#if OPT_P11
        { pg8::Gemm g{F.A0() - 1024, F.Wup1(), LAT, FF2, 1024, 1}; pg8::StaticOrder S; S.init2((LAT + 247) / 248, FF2 / 256, (int)gridDim.x, (int)blockIdx.x);
          mk::EpiUpConvMK E{F.ssq(), F.bup() + 9 * FF2, F.conv_w() + 3 * FF2, F.conv_b() + FF2, F.G(), LAT};
          pg8::gemm_phase<mk::EpiUpConvMK, pg8::StaticOrder, PG8_ALIGN, PG8_SP2>(F.lds, g, S, E); }
#else
        for (int c0 = 0; c0 < LAT; c0 += 4608) { const int c1 = c0 + 4608 > LAT ? LAT : c0 + 4608, rb = c0 - 1, re = c1 + 1;
            gemm_naive_phase(F, F.A0(), F.Wup1(), FF2, 1024, rb, re, EpiUp{F.UCH(), rb, F.ssq(), F.bup() + 9 * FF2}); GRID_BAR(); ph_convgate(F, 1, rb, c0, c1); if (c1 < LAT) GRID_BAR(); }
#endif
    }
    SEAM(11);
    if (IN(12)) {
#if OPT_P12
        { pg8::Gemm g{F.G(), F.Wdn1(), LAT, 1024, FF, 0}; pg8::StaticOrder S; S.init(LAT, 1024, (int)gridDim.x, (int)blockIdx.x);
          mk::EpiResidMK E{F.out(), F.xc(), F.out(), F.xc(), F.mods() + 9 * 6144 + 5 * 1024, nullptr, nullptr, nullptr};
          pg8::gemm_phase<mk::EpiResidMK, pg8::StaticOrder, PG8_ALIGN, PG8_SP2>(F.lds, g, S, E); }
#else
        gemm_naive_phase(F, F.G(), F.Wdn1(), 1024, FF, 0, LAT, EpiResid{F.out(), F.xc(), F.out(), F.xc(), F.mods() + 9 * 6144 + 5 * 1024, nullptr, nullptr});
#endif
    }
    SEAM(12);
    if (IN(13)) ph_final(F);
}

extern "C" void kernel_launch(void* const* d_in, const int* in_sizes, int n_in, void* d_out, int out_size, void* d_ws, size_t ws_size, hipStream_t st) {
    static int grid = 0;
    if (grid == 0) {
        if (n_in != 24 || ws_size < WS_END || out_size != LAT * D) { fprintf(stderr, "kernel_launch: unexpected shapes (n_in %d, ws %zu, out %d)\n", n_in, ws_size, out_size); grid = -1; return; }
        int dev = 0, cus = 0;
        if (hipGetDevice(&dev) != hipSuccess || hipDeviceGetAttribute(&cus, hipDeviceAttributeMultiprocessorCount, dev) != hipSuccess) { grid = -1; return; }
        if (hipFuncSetAttribute((const void*)mk_fwd, hipFuncAttributeMaxDynamicSharedMemorySize, LDS_BYTES) != hipSuccess) { fprintf(stderr, "kernel_launch: hipFuncSetAttribute failed\n"); grid = -1; return; }
        int per_cu = 0; (void)hipOccupancyMaxActiveBlocksPerMultiprocessor(&per_cu, (const void*)mk_fwd, NTHR, LDS_BYTES); (void)hipGetLastError();
        if (per_cu < 1) fprintf(stderr, "kernel_launch: occupancy query reports %d\n", per_cu);
        grid = cus;
    }
    if (grid < 0) return;
    (void)hipMemsetAsync((char*)d_ws + OFF_CTL, 0, CTL_ZERO_BYTES, st);
    Args a{};
    for (int i = 0; i < 24; ++i) a.in[i] = (const float*)d_in[i];
    a.out = (float*)d_out; a.ws = (unsigned char*)d_ws; a.ph_lo = 0; a.ph_hi = NPHASE;
    hipLaunchKernelGGL(mk_fwd, dim3(grid), dim3(NTHR), LDS_BYTES, st, a);
}
```

```cpp
#include <hip/hip_runtime.h>
#include <cstdint>
#include <cstdio>

typedef unsigned short bf16_t;
typedef _Float16 f16_t;

namespace cfg {
constexpr int D = 1024, BATCH = 8, SEQ = 2048, CTXL = 256;
constexpr int LAT = BATCH * SEQ, CTXR = BATCH * CTXL, ROWS = LAT + CTXR;
constexpr int EVN = 2048, HGN = 5120, FF = 2816, FF2 = 5632;
constexpr float EPS = 1e-6f;
constexpr float QSCALE = 0.125f * 1.4426950408889634f;
constexpr size_t MiB = 1u << 20;
constexpr size_t OFF_CTL = 0, CTL_ZERO_BYTES = 64 * 1024;
constexpr size_t OFF_MODS = 1 * MiB;
constexpr size_t OFF_ROPE = 1 * MiB + 512 * 1024;
constexpr size_t OFF_MISC = OFF_ROPE + 8192;
constexpr size_t OFF_BUP = 2 * MiB;
constexpr size_t OFF_BIN1 = 2 * MiB + 512 * 1024;
constexpr size_t OFF_SSQ = 2 * MiB + 768 * 1024;
constexpr size_t OFF_WIN1 = 4 * MiB, OFF_WOUT1 = 250 * MiB, OFF_WUP1 = 190 * MiB, OFF_WDN1 = 201 * MiB;
constexpr size_t OFF_XC = 32 * MiB + 512 * 1024;
constexpr size_t OFF_A = 41 * MiB;
constexpr size_t OFF_WIN0 = 78 * MiB, OFF_WOUT0 = 82 * MiB, OFF_WUP0 = 84 * MiB, OFF_WDN0 = 95 * MiB;
constexpr size_t OFF_B = 100 * MiB + 512 * 1024;
constexpr size_t OFF_P0 = OFF_B;
constexpr size_t OFF_A1 = OFF_B + 72 * MiB;
constexpr size_t OFF_ON = OFF_A1 + 36 * MiB;
constexpr size_t OFF_G = OFF_B;
constexpr size_t OFF_UCH = OFF_B + 99 * MiB;
constexpr size_t OFF_Q1 = 78 * MiB, OFF_GG1 = 110 * MiB, OFF_V1 = 142 * MiB, OFF_LF1 = 178 * MiB, OFF_LB1 = 214 * MiB;
constexpr size_t OFF_OF = OFF_A, OFF_OB = 4 * MiB;
constexpr size_t OFF_A3 = OFF_Q1;
constexpr size_t WS_END = 256 * MiB;
static_assert(OFF_ON + 36 * MiB <= WS_END && OFF_UCH + (size_t)4610 * 5632 * 2 <= WS_END && OFF_LB1 + 36 * MiB <= OFF_WOUT1 && OFF_WOUT1 + 2 * MiB <= WS_END && OFF_OB + 32 * MiB <= OFF_A, "ws map");
constexpr int NTHR = 512, LDS_BYTES = 147456;
constexpr int LDS_MISC = 140 * 1024;
}
using namespace cfg;

#define GAS __attribute__((address_space(1)))
#define LAS __attribute__((address_space(3)))
__device__ __forceinline__ float bf2f(bf16_t v) { return __uint_as_float((unsigned)v << 16); }
__device__ __forceinline__ bf16_t f2bf(float f) { unsigned u = __float_as_uint(f); return (bf16_t)((u + 0x7fffu + ((u >> 16) & 1u)) >> 16); }
__device__ __forceinline__ unsigned pk2(float lo, float hi) { return (unsigned)f2bf(lo) | ((unsigned)f2bf(hi) << 16); }
__device__ __forceinline__ float silu_f(float x) { return x / (1.f + expf(-x)); }
__device__ __forceinline__ float wave_sum(float v) {
#pragma unroll
    for (int o = 1; o < 64; o <<= 1) v += __shfl_xor(v, o);
    return v;
}
__device__ __forceinline__ int mod_row(int row) { return row < LAT ? (row >> 11) : 8; }
__device__ __forceinline__ float rstd_of(const float* ssq, int row) { const float4* p = (const float4*)(ssq + (size_t)row * 16); float t = 0.f;
#pragma unroll
    for (int i = 0; i < 4; ++i) { const float4 s = p[i]; t += (s.x + s.y) + (s.z + s.w); }
    return rsqrtf(t * (1.f / D) + EPS); }

#define XB_TMO      128
#define XB_XCNT(j)  (256  + 64 * (j))
#define XB_XSUB(j)  (1280 + 64 * (j))
#define XB_XGEN(j)  (2304 + 64 * (j))
#define XB_TOP      3328
#define XB_TOPGEN   3392
#define XCD_BAR_WORDS 3456
#define XB_SPIN_CAP (1u << 18)
__device__ __forceinline__ unsigned xb_ld(unsigned* p)              { return __hip_atomic_load(p, __ATOMIC_RELAXED, __HIP_MEMORY_SCOPE_AGENT); }
__device__ __forceinline__ unsigned xb_add(unsigned* p, unsigned v) { return __hip_atomic_fetch_add(p, v, __ATOMIC_RELAXED, __HIP_MEMORY_SCOPE_AGENT); }
__device__ __forceinline__ unsigned xb_xcc_id() { return (unsigned)__builtin_amdgcn_s_getreg((3 << 11) | 20) & 0xFu; }
#define XB_SPIN(cond, bar) do { unsigned _sp = 0; while (cond) { __builtin_amdgcn_s_sleep(1); \
    if ((++_sp & 255u) == 0u) { if (xb_ld(&(bar)[XB_TMO])) break; if (_sp > XB_SPIN_CAP) { atomicAdd(&(bar)[XB_TMO], 1u); break; } } } } while (0)
struct XcdBarrier { unsigned* bar; unsigned x; volatile LAS unsigned* st; };
__device__ __forceinline__ XcdBarrier xcd_barrier_post(unsigned* bar, volatile LAS unsigned* st) {
    XcdBarrier b; b.bar = bar; b.x = xb_xcc_id(); b.st = st;
    if (threadIdx.x == 0) (void)xb_add(&bar[XB_XCNT(b.x)], 1u);
    return b;
}
__device__ __forceinline__ void xcd_barrier_complete(unsigned* bar, unsigned x, unsigned& nloc, unsigned& nx) {
    const unsigned G = gridDim.x * gridDim.y * gridDim.z;
    unsigned sum, cnt, mine, sp = 0u;
    for (;;) {
        sum = 0u; cnt = 0u; mine = 0u;
#pragma unroll
        for (unsigned j = 0; j < 16; ++j) { const unsigned c = xb_ld(&bar[XB_XCNT(j)]); sum += c; cnt += (c > 0u) ? 1u : 0u; mine = (j == x) ? c : mine; }
        if (sum == G) break;
        __builtin_amdgcn_s_sleep(1);
        if ((++sp & 255u) == 0u) { if (xb_ld(&bar[XB_TMO])) break; if (sp > XB_SPIN_CAP) { atomicAdd(&bar[XB_TMO], 1u); break; } }
    }
    nloc = mine > 0u ? mine : 1u; nx = cnt > 0u ? cnt : 1u;
}
__device__ __forceinline__ void xcd_barrier(const XcdBarrier& b) {
    asm volatile("s_waitcnt vmcnt(0)" ::: "memory");
    __syncthreads();
    if (threadIdx.x == 0) {
        unsigned* bar = b.bar;
        __builtin_amdgcn_s_waitcnt(0);
        unsigned nloc = b.st[0], nx = b.st[1];
        if (nloc == 0u) { xcd_barrier_complete(bar, b.x, nloc, nx); b.st[0] = nloc; b.st[1] = nx; }
        const unsigned old = xb_add(&bar[XB_XSUB(b.x)], 1u);
        const unsigned gen = old / nloc;
        if (old + 1u == (gen + 1u) * nloc) {
            __builtin_amdgcn_fence(__ATOMIC_RELEASE, "agent");
            asm volatile("s_waitcnt vmcnt(0)" ::: "memory");
            const unsigned og = xb_add(&bar[XB_TOP], 1u);
            const unsigned tg = og / nx;
            if (og + 1u == (tg + 1u) * nx) xb_add(&bar[XB_TOPGEN], 1u);
            else XB_SPIN(xb_ld(&bar[XB_TOPGEN]) == tg, bar);
            __builtin_amdgcn_fence(__ATOMIC_ACQUIRE, "agent");
            xb_add(&bar[XB_XGEN(b.x)], 1u);
            asm volatile("s_waitcnt vmcnt(0)" ::: "memory");
        } else {
            XB_SPIN(xb_ld(&bar[XB_XGEN(b.x)]) == gen, bar);
            __builtin_amdgcn_fence(__ATOMIC_ACQUIRE, "agent");
            asm volatile("s_waitcnt vmcnt(0)" ::: "memory");
        }
    }
    __syncthreads();
}

struct Args { const float* in[24]; float* out; unsigned char* ws; int ph_lo, ph_hi; };
struct Frame {
    const Args& A; LAS unsigned char* lds; int tid, lane, wave, gw, NGW, gt, NGT;
    __device__ __forceinline__ Frame(const Args& a) : A(a) {}
    __device__ __forceinline__ const float* x() const { return A.in[0]; }
    __device__ __forceinline__ const float* c() const { return A.in[1]; }
    __device__ __forceinline__ const float* ctx() const { return A.in[2]; }
    __device__ __forceinline__ const float* c_ctx() const { return A.in[3]; }
    __device__ __forceinline__ const float* w_mod() const { return A.in[4]; }
    __device__ __forceinline__ const float* b_mod() const { return A.in[5]; }
    __device__ __forceinline__ const float* ev_w_in() const { return A.in[6]; }
    __device__ __forceinline__ const float* ev_w_out() const { return A.in[7]; }
    __device__ __forceinline__ const float* lq1() const { return A.in[8]; }
    __device__ __forceinline__ const float* lk1() const { return A.in[9]; }
    __device__ __forceinline__ const float* lq2() const { return A.in[10]; }
    __device__ __forceinline__ const float* lk2() const { return A.in[11]; }
    __device__ __forceinline__ const float* subln() const { return A.in[12]; }
    __device__ __forceinline__ const float* pool_w() const { return A.in[13]; }
    __device__ __forceinline__ const float* pool_scale() const { return A.in[14]; }
    __device__ __forceinline__ const float* hg_w_in() const { return A.in[15]; }
    __device__ __forceinline__ const float* hg_w_out() const { return A.in[16]; }
    __device__ __forceinline__ const float* lb_logits() const { return A.in[17]; }
    __device__ __forceinline__ const float* hg_norm() const { return A.in[18]; }
    __device__ __forceinline__ const float* w_up() const { return A.in[19]; }
    __device__ __forceinline__ const float* conv_w() const { return A.in[20]; }
    __device__ __forceinline__ const float* conv_b() const { return A.in[21]; }
    __device__ __forceinline__ const float* w_down() const { return A.in[22]; }
    __device__ __forceinline__ const float* final_norm() const { return A.in[23]; }
    __device__ __forceinline__ float* out() const { return A.out; }
    __device__ __forceinline__ unsigned char* ws() const { return A.ws; }
    __device__ __forceinline__ float* mods() const { return (float*)(A.ws + OFF_MODS); }
    __device__ __forceinline__ float* rope() const { return (float*)(A.ws + OFF_ROPE); }
    __device__ __forceinline__ float* misc() const { return (float*)(A.ws + OFF_MISC); }
    __device__ __forceinline__ float* ssq() const { return (float*)(A.ws + OFF_SSQ); }
    __device__ __forceinline__ float* bup() const { return (float*)(A.ws + OFF_BUP); }
    __device__ __forceinline__ float* bin1() const { return (float*)(A.ws + OFF_BIN1); }
    __device__ __forceinline__ float* xc() const { return (float*)(A.ws + OFF_XC); }
    __device__ __forceinline__ bf16_t* Win0() const { return (bf16_t*)(A.ws + OFF_WIN0); }
    __device__ __forceinline__ bf16_t* Wout0() const { return (bf16_t*)(A.ws + OFF_WOUT0); }
    __device__ __forceinline__ bf16_t* Wup0() const { return (bf16_t*)(A.ws + OFF_WUP0); }
    __device__ __forceinline__ bf16_t* Wdn0() const { return (bf16_t*)(A.ws + OFF_WDN0); }
    __device__ __forceinline__ bf16_t* Win1() const { return (bf16_t*)(A.ws + OFF_WIN1); }
    __device__ __forceinline__ bf16_t* Wout1() const { return (bf16_t*)(A.ws + OFF_WOUT1); }
    __device__ __forceinline__ bf16_t* Wup1() const { return (bf16_t*)(A.ws + OFF_WUP1); }
    __device__ __forceinline__ bf16_t* Wdn1() const { return (bf16_t*)(A.ws + OFF_WDN1); }
    __device__ __forceinline__ bf16_t* A0() const { return (bf16_t*)(A.ws + OFF_A); }
    __device__ __forceinline__ bf16_t* A1() const { return (bf16_t*)(A.ws + OFF_A1); }
    __device__ __forceinline__ bf16_t* P0() const { return (bf16_t*)(A.ws + OFF_P0); }
    __device__ __forceinline__ bf16_t* ON() const { return (bf16_t*)(A.ws + OFF_ON); }
    __device__ __forceinline__ bf16_t* G() const { return (bf16_t*)(A.ws + OFF_G); }
    __device__ __forceinline__ bf16_t* UCH() const { return (bf16_t*)(A.ws + OFF_UCH); }
    __device__ __forceinline__ bf16_t* Q1() const { return (bf16_t*)(A.ws + OFF_Q1); }
    __device__ __forceinline__ bf16_t* GG1() const { return (bf16_t*)(A.ws + OFF_GG1); }
    __device__ __forceinline__ bf16_t* V1() const { return (bf16_t*)(A.ws + OFF_V1); }
    __device__ __forceinline__ bf16_t* OF() const { return (bf16_t*)(A.ws + OFF_OF); }
    __device__ __forceinline__ bf16_t* OB() const { return (bf16_t*)(A.ws + OFF_OB); }
    __device__ __forceinline__ bf16_t* A3() const { return (bf16_t*)(A.ws + OFF_A3); }
    __device__ __forceinline__ f16_t* LF1() const { return (f16_t*)(A.ws + OFF_LF1); }
    __device__ __forceinline__ f16_t* LB1() const { return (f16_t*)(A.ws + OFF_LB1); }
};

__device__ __forceinline__ void ph_mods(Frame& F) {
    LAS float* s = (LAS float*)F.lds;
    LAS float* red = (LAS float*)(F.lds + 36864);
    if ((int)blockIdx.x >= 192) return;
    for (int i = F.tid; i < 9 * 1024; i += NTHR) { const int r = i >> 10, k = i & 1023; s[i] = silu_f(r < 8 ? F.c()[r * 1024 + k] : F.c_ctx()[k]); }
    __syncthreads();
    const int kg = F.tid >> 6, cl = F.tid & 63;
    for (int item = blockIdx.x; item < 192; item += gridDim.x) {
        const int l = item / 96, col = (item % 96) * 64 + cl;
        float acc[9];
#pragma unroll
        for (int r = 0; r < 9; ++r) acc[r] = 0.f;
        const float* w = F.w_mod() + (size_t)l * 1024 * 6144 + col;
        for (int k = kg * 128; k < kg * 128 + 128; ++k) { const float wv = w[(size_t)k * 6144];
#pragma unroll
            for (int r = 0; r < 9; ++r) acc[r] += s[r * 1024 + k] * wv; }
#pragma unroll
        for (int r = 0; r < 9; ++r) red[(kg * 9 + r) * 64 + cl] = acc[r];
        __syncthreads();
        if (kg == 0) {
#pragma unroll
            for (int r = 0; r < 9; ++r) { float t = 0.f;
#pragma unroll
                for (int g = 0; g < 8; ++g) t += red[(g * 9 + r) * 64 + cl];
                F.mods()[((size_t)l * 9 + r) * 6144 + col] = F.b_mod()[l * 6144 + col] + t; }
        }
        __syncthreads();
    }
}
__device__ __forceinline__ void ph_small(Frame& F) {
    if (blockIdx.x != gridDim.x - 1) return;
    const int tid = F.tid;
    if (tid == 0) { float s1 = 0.f, s2 = 0.f; for (int i = 0; i < 64; ++i) { s1 += F.lq1()[i] * F.lk1()[i]; s2 += F.lq2()[i] * F.lk2()[i]; } F.misc()[0] = expf(s1) - expf(s2) + 0.2f; }
    F.misc()[64 + tid] = F.subln()[tid] * 0.8f;
    for (int i = tid; i < 2048; i += NTHR) { const int dir = i >> 10, ch = i & 1023; const float l0 = F.lb_logits()[(dir * 2 + 0) * 1024 + ch], l1 = F.lb_logits()[(dir * 2 + 1) * 1024 + ch];
        const float m = fmaxf(l0, l1), e0 = expf(l0 - m), e1 = expf(l1 - m); F.misc()[1024 + i] = e1 / (e0 + e1); }
    for (int i = tid; i < 1024; i += NTHR) { const int pos = i >> 4, f = i & 15; const float inv = powf(10000.0f, -(float)f / 16.0f); const float ang = (float)pos * inv; F.rope()[i] = cosf(ang); F.rope()[1024 + i] = sinf(ang); }
}
__device__ __forceinline__ void transpose_item(const float* W, int K, int N, bf16_t* WT, int ldt, int mode, LAS float* scr, int item, int lane) {
    const int nblk = N / 32, kb = item / nblk, nb = item % nblk, k0 = 64 * kb, n0 = 32 * nb;
#pragma unroll 8
    for (int i = 0; i < 32; ++i) { const int kk = 2 * i + (lane >> 5); scr[kk * 33 + (lane & 31)] = W[(size_t)(k0 + kk) * N + n0 + (lane & 31)]; }
    asm volatile("s_waitcnt lgkmcnt(0)" ::: "memory");
    const int c = lane & 7;
#pragma unroll
    for (int j = 0; j < 4; ++j) { const int nn = (lane >> 3) + 8 * j; const LAS float* s = scr + (8 * c) * 33 + nn;
        uint4 o; o.x = pk2(s[0 * 33], s[1 * 33]); o.y = pk2(s[2 * 33], s[3 * 33]); o.z = pk2(s[4 * 33], s[5 * 33]); o.w = pk2(s[6 * 33], s[7 * 33]);
        const int n = n0 + nn; int np = n;
        if (mode == 1) { const int ch = n < FF ? n : n - FF; np = (ch >> 7) * 256 + (ch & 127) + (n < FF ? 0 : 128); }
        *(uint4*)(WT + (size_t)np * ldt + k0 + 8 * c) = o; }
    asm volatile("s_waitcnt lgkmcnt(0)" ::: "memory");
}
__device__ __forceinline__ void ph_transposes(Frame& F) {
    LAS float* scr = (LAS float*)(F.lds + 57344 + F.wave * 8448);
    constexpr int I0 = 16 * 64, I1 = 8 * 32, I2 = 16 * 176, I3 = 44 * 32, I4 = 16 * 160, I5 = 16 * 32;
    constexpr int NIT = I0 + I1 + I2 + I3 + I4 + I5;
    for (int it = F.gw; it < NIT; it += F.NGW) {
        int r = it;
        if (r < I0) { transpose_item(F.ev_w_in(), 1024, EVN, F.Win0(), 1024, 0, scr, r, F.lane); continue; } r -= I0;
        if (r < I1) { transpose_item(F.ev_w_out(), 512, 1024, F.Wout0(), 1024, 0, scr, r, F.lane); continue; } r -= I1;
        if (r < I2) { transpose_item(F.w_up(), 1024, FF2, F.Wup0(), 1024, 1, scr, r, F.lane); continue; } r -= I2;
        if (r < I3) { transpose_item(F.w_down(), FF, 1024, F.Wdn0(), FF, 0, scr, r, F.lane); continue; } r -= I3;
        if (r < I4) { transpose_item(F.hg_w_in(), 1024, HGN, F.Win1(), 1024, 0, scr, r, F.lane); continue; } r -= I4;
        transpose_item(F.hg_w_out(), 1024, 1024, F.Wout1(), 1024, 0, scr, r, F.lane);
    }
}
__device__ __forceinline__ void ph_transposes_l1ffn(Frame& F) {
    LAS float* scr = (LAS float*)(F.lds + 57344 + F.wave * 8448);
    constexpr int I6 = 16 * 176, I7 = 44 * 32;
    for (int it = F.gw; it < I6 + I7; it += F.NGW) {
        if (it < I6) transpose_item(F.w_up() + (size_t)1024 * FF2, 1024, FF2, F.Wup1(), 1024, 1, scr, it, F.lane);
        else transpose_item(F.w_down() + (size_t)FF * 1024, FF, 1024, F.Wdn1(), FF, 0, scr, it - I6, F.lane);
    }
}
__device__ __forceinline__ void ph_weff(Frame& F) {
    for (int idx = F.gt; idx < 512 * 1024; idx += F.NGT) { const int gc = idx >> 10, n = idx & 1023, g = gc >> 7;
        float acc = 0.f;
        for (int d = 0; d < 128; ++d) acc += F.pool_w()[(size_t)gc * 128 + d] * F.pool_scale()[g * 128 + d] * F.ev_w_out()[(size_t)(512 + g * 128 + d) * 1024 + n];
        F.Wout0()[(size_t)n * 1024 + 512 + gc] = f2bf(acc); }
}
__device__ __forceinline__ void bias_item(const float* mods_l, int chunk, const bf16_t* Wt, int N, float* bias, int n, int lane) {
    float acc[9];
#pragma unroll
    for (int r = 0; r < 9; ++r) acc[r] = 0.f;
    for (int k = lane; k < 1024; k += 64) { const float w = bf2f(Wt[(size_t)n * 1024 + k]);
#pragma unroll
        for (int r = 0; r < 9; ++r) acc[r] += mods_l[(size_t)r * 6144 + chunk * 1024 + k] * w; }
#pragma unroll
    for (int r = 0; r < 9; ++r) { const float s = wave_sum(acc[r]); if (lane == 0) bias[(size_t)r * N + n] = s; }
}
__device__ __forceinline__ void ph_bias(Frame& F) {
    for (int it = F.gw; it < FF2 + HGN; it += F.NGW) {
        if (it < FF2) bias_item(F.mods(), 3, F.Wup0(), FF2, F.bup(), it, F.lane);
        else bias_item(F.mods() + 9 * 6144, 0, F.Win1(), HGN, F.bin1(), it - FF2, F.lane);
    }
}
__device__ __forceinline__ void ph_bias_up1(Frame& F) {
    for (int it = F.gw; it < FF2; it += F.NGW) bias_item(F.mods() + 9 * 6144, 3, F.Wup1(), FF2, F.bup() + 9 * FF2, it, F.lane);
}
__device__ __forceinline__ void ph_norm_mod(Frame& F) {
    for (int row = F.gw; row < ROWS; row += F.NGW) {
        const float* xr = row < LAT ? F.x() + (size_t)row * D : F.ctx() + (size_t)(row - LAT) * D;
        const float* m = F.mods() + (size_t)mod_row(row) * 6144;
        float4 v[4]; float s = 0.f;
#pragma unroll
        for (int j = 0; j < 4; ++j) { v[j] = *(const float4*)(xr + j * 256 + F.lane * 4); s += (v[j].x * v[j].x + v[j].y * v[j].y) + (v[j].z * v[j].z + v[j].w * v[j].w); }
        const float rstd = rsqrtf(wave_sum(s) * (1.f / D) + EPS);
#pragma unroll
        for (int j = 0; j < 4; ++j) { const int c0 = j * 256 + F.lane * 4; const float4 sh = *(const float4*)(m + c0), sc = *(const float4*)(m + 1024 + c0);
            uint2 o; o.x = pk2(v[j].x * rstd * (1.f + sc.x) + sh.x, v[j].y * rstd * (1.f + sc.y) + sh.y); o.y = pk2(v[j].z * rstd * (1.f + sc.z) + sh.z, v[j].w * rstd * (1.f + sc.w) + sh.w);
            *(uint2*)(F.A0() + (size_t)row * D + c0) = o; }
    }
}
__device__ __forceinline__ void ph_rowssq(Frame& F, int nrows) {
    for (int row = F.gw; row < nrows; row += F.NGW) {
        const float* xr = row < LAT ? F.out() + (size_t)row * D : F.xc() + (size_t)(row - LAT) * D;
        float s = 0.f;
#pragma unroll
        for (int j = 0; j < 4; ++j) { const float4 v = *(const float4*)(xr + j * 256 + F.lane * 4); s += (v.x * v.x + v.y * v.y) + (v.z * v.z + v.w * v.w); }
        s = wave_sum(s);
        if (F.lane < 16) F.ssq()[(size_t)row * 16 + F.lane] = F.lane == 0 ? s : 0.f;
    }
}

template <class Epi>
__device__ __forceinline__ void gemm_naive_phase(Frame& F, const bf16_t* A, const bf16_t* Bt, int N, int K, int rowBeg, int rowEnd, const Epi& epi) {
    const int half = F.tid >> 8, tid = F.tid & 255, tx = tid & 15, ty = tid >> 4;
    LAS float* As = (LAS float*)(F.lds + half * 8320); LAS float* Bs = As + 16 * 65;
    const int tn = N / 64, tm = (rowEnd - rowBeg + 63) / 64, ntiles = tn * tm;
    const int lr = tid >> 2, lk = (tid & 3) * 4;
    for (int i = blockIdx.x; 2 * i < ntiles; i += gridDim.x) {
        const int tile = 2 * i + half, r0 = rowBeg + (tile / tn) * 64, c0 = (tile % tn) * 64;
        float acc[4][4];
#pragma unroll
        for (int a = 0; a < 4; ++a)
#pragma unroll
            for (int b = 0; b < 4; ++b) acc[a][b] = 0.f;
        int arow = r0 + lr; if (arow > rowEnd - 1) arow = rowEnd - 1;
        const bf16_t* ap = A + (long)arow * K + lk;
        const bf16_t* bp = Bt + (size_t)(c0 + lr) * K + lk;
        for (int k0 = 0; k0 < K; k0 += 16) {
            const ushort4 av = *(const ushort4*)(ap + k0), bv = *(const ushort4*)(bp + k0);
            As[(lk + 0) * 65 + lr] = bf2f(av.x); As[(lk + 1) * 65 + lr] = bf2f(av.y); As[(lk + 2) * 65 + lr] = bf2f(av.z); As[(lk + 3) * 65 + lr] = bf2f(av.w);
            Bs[(lk + 0) * 65 + lr] = bf2f(bv.x); Bs[(lk + 1) * 65 + lr] = bf2f(bv.y); Bs[(lk + 2) * 65 + lr] = bf2f(bv.z); Bs[(lk + 3) * 65 + lr] = bf2f(bv.w);
            __syncthreads();
#pragma unroll
            for (int k = 0; k < 16; ++k) { float a[4], b[4];
#pragma unroll
                for (int q = 0; q < 4; ++q) { a[q] = As[k * 65 + ty * 4 + q]; b[q] = Bs[k * 65 + tx * 4 + q]; }
#pragma unroll
                for (int q = 0; q < 4; ++q)
#pragma unroll
                    for (int j = 0; j < 4; ++j) acc[q][j] += a[q] * b[j]; }
            __syncthreads();
        }
#pragma unroll
        for (int q = 0; q < 4; ++q) { const int row = r0 + ty * 4 + q; if (row < rowEnd) {
#pragma unroll
            for (int j = 0; j < 4; ++j) epi(row, c0 + tx * 4 + j, acc[q][j]); } }
    }
}
struct EpiStore { bf16_t* C; long long ldc; __device__ void operator()(int row, int col, float v) const { C[(size_t)row * ldc + col] = f2bf(v); } };
struct EpiUp { bf16_t* U; long long rowBase; const float* ssq; const float* bias;
    __device__ void operator()(int row, int col, float v) const { if (row < 0 || row >= ROWS) return; U[(size_t)(row - rowBase) * FF2 + col] = f2bf(rstd_of(ssq, row) * v + bias[(size_t)mod_row(row) * FF2 + col]); } };
struct EpiResid { const float* xin_lat; const float* xin_ctx; float* xout_lat; float* xout_ctx; const float* gate; const float* scale_next; bf16_t* An;
    __device__ void operator()(int row, int col, float v) const {
        const int r = mod_row(row); const size_t o = row < LAT ? (size_t)row * D + col : (size_t)(row - LAT) * D + col;
        const float xo = (row < LAT ? xin_lat : xin_ctx)[o]; const float xn = xo + gate[(size_t)r * 6144 + col] * v;
        (row < LAT ? xout_lat : xout_ctx)[o] = xn;
        if (An) An[(size_t)row * D + col] = f2bf(xn * (1.f + scale_next[(size_t)r * 6144 + col])); } };
struct EpiIn1 { const float* ssq; const float* bias; const float* lbv; bf16_t* Q; bf16_t* GG; bf16_t* V; f16_t* LF; f16_t* LB;
    __device__ void operator()(int row, int col, float acc) const {
        const int blk = col >> 10, ch = col & 1023; const float val = rstd_of(ssq, row) * acc + bias[(size_t)mod_row(row) * HGN + col];
        if (blk == 0) { if (row < LAT) Q[(size_t)row * D + ch] = f2bf(silu_f(val)); }
        else if (blk == 1) V[(size_t)row * D + ch] = f2bf(val);
        else if (blk == 4) { if (row < LAT) GG[(size_t)row * D + ch] = f2bf(silu_f(val)); }
        else { const float lb = lbv[(blk - 2) * 1024 + ch]; const float f = lb + (1.f - lb) / (1.f + expf(-val)); (blk == 2 ? LF : LB)[(size_t)row * D + ch] = (f16_t)f; } } };


namespace pg8 {
#define PG8_LAS __attribute__((address_space(3)))
typedef unsigned short bf16_t;
typedef short bf16x8 __attribute__((ext_vector_type(8)));
typedef float f32x4 __attribute__((ext_vector_type(4)));
typedef unsigned u32x4 __attribute__((ext_vector_type(4)));
constexpr int BM = 256, BK = 64, HALF = 128, HTB = HALF * BK * 2  , STAGE_BYTES = 8 * HTB, NXCD = 8, WGM = 8;

__host__ __device__ __forceinline__ int lds_byte(int r, int c) { const int st = (r >> 4) * 2 + (c >> 5), rr = r & 15, cc = c & 31, ob = rr * 64 + cc * 2; return st * 1024 + (ob ^ (((ob >> 9) & 1) << 5)); }
__host__ __device__ __forceinline__ void stage_rc(int b, int& R, int& C) { const int st = b / 1024, sb = b % 1024, swz = sb ^ (((sb >> 9) & 1) << 5); R = (st >> 1) * 16 + swz / 64; C = (st & 1) * 32 + (swz % 64) / 2; }
__host__ __device__ __forceinline__ int perm32(int rho) { const int n = rho >> 4, i = rho & 15; return 8 * (i >> 2) + 4 * n + (i & 3); }

struct Unit { int pm, pn; };
struct Gemm { const bf16_t* A; const bf16_t* Bt; int M, N, K; int achunk; };

struct StaticOrder {
    int nM, nN, nwg, G, c;
    __host__ __device__ void init(int M, int N, int G_, int c_) { nM = M / BM; nN = N / BM; nwg = nM * nN; G = G_; c = c_; }
    __host__ __device__ void init2(int nM_, int nN_, int G_, int c_) { nM = nM_; nN = nN_; nwg = nM * nN; G = G_; c = c_; }
    __host__ __device__ bool next(int i, Unit& u) const {
        const long L = (long)i * G + c; if (L >= nwg) return false;
        int wgid = (int)L; { const int q = nwg / NXCD, r = nwg % NXCD, xcd = wgid % NXCD, off = wgid / NXCD; wgid = (xcd < r ? xcd * (q + 1) : r * (q + 1) + (xcd - r) * q) + off; }
        const int nig = WGM * nN, gid = wgid / nig, fm = gid * WGM, gsz = (nM - fm) < WGM ? (nM - fm) : WGM;
        u.pm = fm + ((wgid % nig) % gsz); u.pn = (wgid % nig) / gsz; return true;
    }
    __device__ __forceinline__ void a_ready(const Unit&) const {}
    __device__ __forceinline__ void done(const Unit&) const {}
};
template <class Epi, class Sched, bool ALIGN_EPI = false, bool SP2 = false>
__device__ __forceinline__ void gemm_phase(PG8_LAS unsigned char* lds, const Gemm g, const Sched& S, const Epi& E) {
    const int tid = threadIdx.x, wid = __builtin_amdgcn_readfirstlane(tid >> 6), lane = tid & 63, wr = wid >> 2, wc = wid & 3, fr = lane & 15, fq = lane >> 4;
    const int K = g.K, nt = K / BK;
    unsigned voffA[2], voffB[2];
#pragma unroll
    for (int i = 0; i < 2; ++i) { int R, C; stage_rc(tid * 16 + i * 8192, R, C); const int Rb = Epi::PERM ? ((R & ~31) + perm32(R & 31)) : R;
        const int Ra = g.achunk ? (62 * (R >> 6) + 4 * (R & 15) + ((R >> 4) & 3)) : R;
        voffA[i] = (unsigned)(Ra * K + C) * 2u; voffB[i] = (unsigned)(Rb * K + C) * 2u; }
    const size_t kstep = (size_t)(BK * 2);
    const size_t hstep = (size_t)HALF * K * 2;
    const size_t tstep = 2 * hstep;
    const size_t hstepA = g.achunk ? (size_t)124 * K * 2 : hstep, tstepA = 2 * hstepA;
    const unsigned ldsw = (unsigned)wid * 1024u;
    const int aoff = lds_byte(wr * 64 + fr, fq * 8), boff = lds_byte(wc * 32 + fr, fq * 8);
#define PG8_SA(b, h) (((b) * 2 + (h)) * HTB)
#define PG8_SB(b, h) ((4 + (b) * 2 + (h)) * HTB)
#define PG8_STAGE(bufoff, gbase, voff) do { _Pragma("unroll") for (int _i = 0; _i < 2; ++_i) \
        __builtin_amdgcn_global_load_lds((const unsigned*)((const char*)(gbase) + (voff)[_i]), (PG8_LAS unsigned*)(lds + (bufoff) + ldsw + _i * 8192), 16, 0, 0); } while (0)
#define PG8_LDA(dst, b, h) do { _Pragma("unroll") for (int m = 0; m < 4; ++m) _Pragma("unroll") for (int k = 0; k < 2; ++k) dst[m][k] = *(const PG8_LAS bf16x8*)(lds + PG8_SA(b, h) + aoff + m * 2048 + k * 1024); } while (0)
#define PG8_LDB(dst, b, h) do { _Pragma("unroll") for (int n = 0; n < 2; ++n) _Pragma("unroll") for (int k = 0; k < 2; ++k) dst[n][k] = *(const PG8_LAS bf16x8*)(lds + PG8_SB(b, h) + boff + n * 2048 + k * 1024); } while (0)
#define PG8_MMA(ai, bj, At, Bt) do { __builtin_amdgcn_s_setprio(1); _Pragma("unroll") for (int m = 0; m < 4; ++m) _Pragma("unroll") for (int n = 0; n < 2; ++n) _Pragma("unroll") for (int k = 0; k < 2; ++k) \
        acc[ai][bj][m][n] = __builtin_amdgcn_mfma_f32_16x16x32_bf16(Bt[n][k], At[m][k], acc[ai][bj][m][n], 0, 0, 0); __builtin_amdgcn_s_setprio(0); } while (0)
#define PG8_WAIT_V(n) asm volatile("s_waitcnt vmcnt(" #n ")" ::: "memory")
#define PG8_WAIT_L(n) asm volatile("s_waitcnt lgkmcnt(" #n ")" ::: "memory")
#define PG8_BAR __builtin_amdgcn_s_barrier()
#define PG8_SCHED __builtin_amdgcn_sched_barrier(0)
    Unit cur, nxt; int ui = 0;
    if (!S.next(0, cur)) return;
    f32x4 acc[2][2][4][2];
#pragma unroll
    for (int a = 0; a < 2; ++a)
#pragma unroll
        for (int b = 0; b < 2; ++b)
#pragma unroll
            for (int m = 0; m < 4; ++m)
#pragma unroll
                for (int n = 0; n < 2; ++n) acc[a][b][m][n] = (f32x4){0.f, 0.f, 0.f, 0.f};
    bf16x8 At[4][2], B0[2][2], B1[2][2];
    const char* cA = (const char*)g.A + (size_t)cur.pm * tstepA; const char* cB = (const char*)g.Bt + (size_t)cur.pn * tstep;
    S.a_ready(cur);
    if constexpr (SP2) {
        PG8_STAGE(PG8_SB(0, 0), cB, voffB); PG8_STAGE(PG8_SB(0, 1), cB + hstep, voffB); PG8_STAGE(PG8_SA(0, 0), cA, voffA); PG8_STAGE(PG8_SA(0, 1), cA + hstepA, voffA);
        if (wr == 1) PG8_BAR;
        PG8_WAIT_V(2); PG8_BAR;
        PG8_STAGE(PG8_SB(1, 0), cB + kstep, voffB); PG8_STAGE(PG8_SA(1, 0), cA + kstep, voffA); PG8_STAGE(PG8_SB(1, 1), cB + hstep + kstep, voffB);
        PG8_WAIT_V(6); PG8_BAR;
    } else {
        PG8_STAGE(PG8_SB(0, 0), cB, voffB); PG8_STAGE(PG8_SA(0, 0), cA, voffA); PG8_STAGE(PG8_SB(0, 1), cB + hstep, voffB); PG8_STAGE(PG8_SA(0, 1), cA + hstepA, voffA);
        if (wr == 1) PG8_BAR;
        PG8_WAIT_V(4); PG8_BAR;
        PG8_STAGE(PG8_SB(1, 0), cB + kstep, voffB); PG8_STAGE(PG8_SA(1, 0), cA + kstep, voffA); PG8_STAGE(PG8_SB(1, 1), cB + hstep + kstep, voffB);
        PG8_WAIT_V(6); PG8_BAR;
    }
    for (;;) {
        const bool has_next = S.next(ui + 1, nxt);
        const char* nA = has_next ? (const char*)g.A + (size_t)nxt.pm * tstepA : cA; const char* nB = has_next ? (const char*)g.Bt + (size_t)nxt.pn * tstep : cB;
        for (int t = 0; t < nt; t += 2) {
            const bool last = (t == nt - 2);
            const char* a1 = cA + (size_t)(t + 1) * kstep;
            const char* a2 = last ? nA : cA + (size_t)(t + 2) * kstep; const char* b2 = last ? nB : cB + (size_t)(t + 2) * kstep;
            const char* a3 = a2 + kstep; const char* b3 = b2 + kstep;
            if (last && has_next) S.a_ready(nxt);
            if constexpr (SP2) {
            PG8_LDB(B0, 0, 0); PG8_LDB(B1, 0, 1); PG8_SCHED; PG8_LDA(At, 0, 0); PG8_STAGE(PG8_SA(1, 1), a1 + hstepA, voffA);
            PG8_WAIT_V(8); PG8_WAIT_L(0); PG8_BAR; PG8_MMA(0, 0, At, B0); PG8_MMA(0, 1, At, B1); PG8_BAR; PG8_SCHED;
            PG8_LDA(At, 0, 1); PG8_STAGE(PG8_SB(0, 0), b2, voffB); PG8_STAGE(PG8_SB(0, 1), b2 + hstep, voffB); PG8_STAGE(PG8_SA(0, 0), a2, voffA);
            PG8_WAIT_V(8); PG8_WAIT_L(0); PG8_BAR; PG8_MMA(1, 0, At, B0); PG8_MMA(1, 1, At, B1); PG8_BAR; PG8_SCHED;
            PG8_LDB(B0, 1, 0); PG8_LDB(B1, 1, 1); PG8_SCHED; PG8_LDA(At, 1, 0); PG8_STAGE(PG8_SA(0, 1), a2 + hstepA, voffA);
            PG8_WAIT_V(8); PG8_WAIT_L(0); PG8_BAR; PG8_MMA(0, 0, At, B0); PG8_MMA(0, 1, At, B1); PG8_BAR; PG8_SCHED;
            PG8_LDA(At, 1, 1); PG8_STAGE(PG8_SB(1, 0), b3, voffB); PG8_STAGE(PG8_SB(1, 1), b3 + hstep, voffB); PG8_STAGE(PG8_SA(1, 0), a3, voffA);
            PG8_WAIT_V(8); PG8_WAIT_L(0); PG8_BAR; PG8_MMA(1, 0, At, B0); PG8_MMA(1, 1, At, B1); PG8_BAR; PG8_SCHED;
            } else {
            PG8_LDB(B0, 0, 0); PG8_SCHED; PG8_LDA(At, 0, 0); PG8_STAGE(PG8_SA(1, 1), a1 + hstepA, voffA);
            PG8_WAIT_L(8); PG8_BAR; PG8_WAIT_L(0); PG8_MMA(0, 0, At, B0); PG8_BAR; PG8_SCHED;
            PG8_LDB(B1, 0, 1); PG8_STAGE(PG8_SB(0, 0), b2, voffB);
            PG8_BAR; PG8_WAIT_L(0); PG8_MMA(0, 1, At, B1); PG8_BAR;
            PG8_LDA(At, 0, 1); PG8_STAGE(PG8_SA(0, 0), a2, voffA);
            PG8_BAR; PG8_WAIT_L(0); PG8_MMA(1, 0, At, B0); PG8_BAR; PG8_SCHED;
            PG8_STAGE(PG8_SB(0, 1), b2 + hstep, voffB);
            PG8_WAIT_V(6); PG8_BAR; PG8_MMA(1, 1, At, B1); PG8_BAR;
            PG8_LDB(B0, 1, 0); PG8_SCHED; PG8_LDA(At, 1, 0); PG8_STAGE(PG8_SA(0, 1), a2 + hstepA, voffA);
            PG8_WAIT_L(8); PG8_BAR; PG8_WAIT_L(0); PG8_MMA(0, 0, At, B0); PG8_BAR; PG8_SCHED;
            PG8_LDB(B1, 1, 1); PG8_STAGE(PG8_SB(1, 0), b3, voffB);
            PG8_BAR; PG8_WAIT_L(0); PG8_MMA(0, 1, At, B1); PG8_BAR;
            PG8_LDA(At, 1, 1); PG8_STAGE(PG8_SA(1, 0), a3, voffA);
            PG8_BAR; PG8_WAIT_L(0); PG8_MMA(1, 0, At, B0); PG8_BAR; PG8_SCHED;
            PG8_STAGE(PG8_SB(1, 1), b3 + hstep, voffB);
            PG8_WAIT_V(6); PG8_BAR; PG8_MMA(1, 1, At, B1); PG8_BAR;
            }
        }
        if constexpr (ALIGN_EPI) { if (wr == 0) PG8_BAR; }
        if constexpr (!Epi::AFTER_DRAIN) { E(acc, cur, wr, wc, fr, fq); S.done(cur); }
        if (!has_next) break;
#pragma unroll
        for (int a = 0; a < 2; ++a)
#pragma unroll
            for (int b = 0; b < 2; ++b)
#pragma unroll
                for (int m = 0; m < 4; ++m)
#pragma unroll
                    for (int n = 0; n < 2; ++n) acc[a][b][m][n] = (f32x4){0.f, 0.f, 0.f, 0.f};
        cur = nxt; cA = nA; cB = nB; ++ui;
        if constexpr (ALIGN_EPI) { if (wr == 1) PG8_BAR; }
    }
    PG8_WAIT_V(0);
    if constexpr (!ALIGN_EPI) { if (wr == 0) PG8_BAR; }
    PG8_BAR;
    if constexpr (Epi::AFTER_DRAIN) { E.fused(acc, cur, wr, wc, fr, fq, lds, wid, lane); S.done(cur); }
#undef PG8_SA
#undef PG8_SB
#undef PG8_STAGE
#undef PG8_LDA
#undef PG8_LDB
#undef PG8_MMA
#undef PG8_WAIT_V
#undef PG8_WAIT_L
#undef PG8_BAR
#undef PG8_SCHED
}
}

#define PG8_ALIGN true
#define PG8_SP2 true
namespace mk {
using pg8::f32x4; using pg8::u32x4; using pg8::Unit; using pg8::BM; using pg8::HALF;
typedef unsigned u32x2 __attribute__((ext_vector_type(2)));
__device__ __forceinline__ unsigned cvt_pk_bf16(float lo, float hi) { unsigned r; asm volatile("v_cvt_pk_bf16_f32 %0, %1, %2" : "=v"(r) : "v"(lo), "v"(hi)); return r; }
__device__ __forceinline__ float rstd16(const float* ssq, int row) { const f32x4* p = (const f32x4*)(ssq + (size_t)row * 16); const f32x4 a = p[0], b = p[1], c = p[2], d = p[3];
    return rsqrtf((((a[0] + a[1]) + (a[2] + a[3])) + ((b[0] + b[1]) + (b[2] + b[3])) + ((c[0] + c[1]) + (c[2] + c[3])) + ((d[0] + d[1]) + (d[2] + d[3]))) * (1.f / D) + EPS); }
struct EpiStoreMK { static constexpr bool PERM = true, AFTER_DRAIN = false; bf16_t* O; long long ldc;
    __device__ __forceinline__ void operator()(const f32x4 (&acc)[2][2][4][2], const Unit& u, int wr, int wc, int fr, int fq) const {
        const int row0 = u.pm * BM + wr * 64 + fr, col0 = u.pn * BM + wc * 32 + 8 * fq;
#pragma unroll
        for (int ai = 0; ai < 2; ++ai)
#pragma unroll
            for (int m = 0; m < 4; ++m) { bf16_t* rowp = O + (size_t)(row0 + ai * HALF + m * 16) * ldc + col0;
#pragma unroll
                for (int bj = 0; bj < 2; ++bj) { const f32x4 v0 = acc[ai][bj][m][0], v1 = acc[ai][bj][m][1];
                    u32x4 w; w.x = cvt_pk_bf16(v0[0], v0[1]); w.y = cvt_pk_bf16(v0[2], v0[3]); w.z = cvt_pk_bf16(v1[0], v1[1]); w.w = cvt_pk_bf16(v1[2], v1[3]);
                    *(u32x4*)(rowp + bj * HALF) = w; } }
    } };
struct EpiResidMK { static constexpr bool PERM = false, AFTER_DRAIN = false;
    const float* xin_lat; const float* xin_ctx; float* xout_lat; float* xout_ctx; const float* gate; const float* scale_next; bf16_t* An; float* ssq;
    __device__ __forceinline__ void operator()(const f32x4 (&acc)[2][2][4][2], const Unit& u, int wr, int wc, int fr, int fq) const {
        const int rowt = u.pm * BM; const bool lat = rowt < LAT; const int r = lat ? (rowt >> 11) : 8;
        const float* xin = lat ? xin_lat + (size_t)rowt * D : xin_ctx + (size_t)(rowt - LAT) * D; float* xout = lat ? xout_lat + (size_t)rowt * D : xout_ctx + (size_t)(rowt - LAT) * D;
        const int colb = u.pn * BM + wc * 32 + 4 * fq;
        float q[2][4];
#pragma unroll
        for (int ai = 0; ai < 2; ++ai)
#pragma unroll
            for (int m = 0; m < 4; ++m) q[ai][m] = 0.f;
#pragma unroll
        for (int bj = 0; bj < 2; ++bj)
#pragma unroll
            for (int n = 0; n < 2; ++n) { const int col = colb + bj * HALF + n * 16;
                const f32x4 gv = *(const f32x4*)(gate + (size_t)r * 6144 + col);
                const f32x4 sv = scale_next ? *(const f32x4*)(scale_next + (size_t)r * 6144 + col) + 1.0f : (f32x4){1.f, 1.f, 1.f, 1.f};
#pragma unroll
                for (int ai = 0; ai < 2; ++ai)
#pragma unroll
                    for (int m = 0; m < 4; ++m) { const size_t off = (size_t)(ai * HALF + wr * 64 + m * 16 + fr) * D + col;
                        const f32x4 xn = *(const f32x4*)(xin + off) + gv * acc[ai][bj][m][n];
                        *(f32x4*)(xout + off) = xn; q[ai][m] += (xn[0] * xn[0] + xn[1] * xn[1]) + (xn[2] * xn[2] + xn[3] * xn[3]);
                        if (An) { const f32x4 a = xn * sv; u32x2 w; w.x = cvt_pk_bf16(a[0], a[1]); w.y = cvt_pk_bf16(a[2], a[3]); *(u32x2*)(An + (size_t)rowt * D + off) = w; } }
                asm volatile("" ::: "memory"); }
        if (ssq) {
#pragma unroll
            for (int ai = 0; ai < 2; ++ai)
#pragma unroll
                for (int m = 0; m < 4; ++m) { float t = q[ai][m]; t += __shfl_xor(t, 16); t += __shfl_xor(t, 32);
                    if (fq == 0) ssq[(size_t)(rowt + ai * HALF + wr * 64 + m * 16 + fr) * 16 + u.pn * 4 + wc] = t; } }
    } };
__device__ __forceinline__ float fast_sigmoid(float x) { return __builtin_amdgcn_rcpf(1.f + __builtin_amdgcn_exp2f(-1.4426950408889634f * x)); }
struct EpiIn1MK { static constexpr bool PERM = true, AFTER_DRAIN = false;
    const float* ssq; const float* bias; const float* lbv; bf16_t* Q; bf16_t* GG; bf16_t* V; f16_t* LF; f16_t* LB;
    template <int KIND>
    __device__ __forceinline__ void body(const f32x4 (&acc)[2][2][4][2], unsigned short* dst, const float* lbp, int rowt, int r, int colb, int chb, int wr, int fr) const {
#pragma unroll
        for (int bj = 0; bj < 2; ++bj) {
            f32x4 bv[2], lbw[2];
#pragma unroll
            for (int n = 0; n < 2; ++n) { bv[n] = *(const f32x4*)(bias + (size_t)r * HGN + colb + bj * HALF + 4 * n);
                lbw[n] = KIND == 2 ? *(const f32x4*)(lbp + chb + bj * HALF + 4 * n) : (f32x4){0.f, 0.f, 0.f, 0.f}; }
#pragma unroll
            for (int ai = 0; ai < 2; ++ai)
#pragma unroll
                for (int m = 0; m < 4; ++m) { const int row = rowt + ai * HALF + wr * 64 + m * 16 + fr; float v[8]; const float rsv = rstd16(ssq, row);
#pragma unroll
                    for (int n = 0; n < 2; ++n)
#pragma unroll
                        for (int e = 0; e < 4; ++e) { float val = rsv * acc[ai][bj][m][n][e] + bv[n][e];
                            if (KIND == 0) val = val * fast_sigmoid(val);
                            else if (KIND == 2) { const float lb = lbw[n][e]; val = lb + (1.f - lb) * fast_sigmoid(val); }
                            v[n * 4 + e] = val; }
                    u32x4 w;
                    if (KIND == 2) { typedef _Float16 h2 __attribute__((ext_vector_type(2)));
                        h2 a = {(_Float16)v[0], (_Float16)v[1]}, b = {(_Float16)v[2], (_Float16)v[3]}, c = {(_Float16)v[4], (_Float16)v[5]}, d = {(_Float16)v[6], (_Float16)v[7]};
                        w.x = __builtin_bit_cast(unsigned, a); w.y = __builtin_bit_cast(unsigned, b); w.z = __builtin_bit_cast(unsigned, c); w.w = __builtin_bit_cast(unsigned, d); }
                    else { w.x = cvt_pk_bf16(v[0], v[1]); w.y = cvt_pk_bf16(v[2], v[3]); w.z = cvt_pk_bf16(v[4], v[5]); w.w = cvt_pk_bf16(v[6], v[7]); }
                    *(u32x4*)(dst + (size_t)row * D + chb + bj * HALF) = w; }
            asm volatile("" ::: "memory"); }
    }
    __device__ __forceinline__ void operator()(const f32x4 (&acc)[2][2][4][2], const Unit& u, int wr, int wc, int fr, int fq) const {
        const int rowt = u.pm * BM; const int r = rowt < LAT ? (rowt >> 11) : 8; const int blk = u.pn >> 2;
        const int colb = u.pn * BM + wc * 32 + 8 * fq, chb = (u.pn & 3) * BM + wc * 32 + 8 * fq;
        if (blk == 0) body<0>(acc, Q, lbv, rowt, r, colb, chb, wr, fr);
        else if (blk == 4) body<0>(acc, GG, lbv, rowt, r, colb, chb, wr, fr);
        else if (blk == 1) body<1>(acc, V, lbv, rowt, r, colb, chb, wr, fr);
        else if (blk == 2) body<2>(acc, (unsigned short*)LF, lbv, rowt, r, colb, chb, wr, fr);
        else body<2>(acc, (unsigned short*)LB, lbv + 1024, rowt, r, colb, chb, wr, fr);
    } };
struct EpiUpConvMK { static constexpr bool PERM = false, AFTER_DRAIN = false;
    const float* ssq; const float* bias; const float* cw; const float* cb; bf16_t* G; long long nrows;
    __device__ __forceinline__ static f32x4 dpp4(const f32x4 v, bool shr) { f32x4 r;
#pragma unroll
        for (int e = 0; e < 4; ++e) r[e] = shr ? __int_as_float(__builtin_amdgcn_update_dpp(0, __float_as_int(v[e]), 0x111, 0xf, 0xf, true)) : __int_as_float(__builtin_amdgcn_update_dpp(0, __float_as_int(v[e]), 0x101, 0xf, 0xf, true));
        return r; }
    __device__ __forceinline__ void conv_block(f32x4 (&o)[4], const f32x4 (&acc)[2][2][4][2], int ai, int bj, int n, const float* wp, const float* bp0, const float (&rs)[4], const int (&rr)[4], const bool (&first)[4], const bool (&last)[4], int colv) const {
        f32x4 uu[4];
#pragma unroll
        for (int m = 0; m < 4; ++m) uu[m] = rs[m] * acc[ai][bj][m][n] + *(const f32x4*)(bias + (size_t)rr[m] * FF2 + colv + bj * HALF);
        const f32x4 w0 = *(const f32x4*)(wp), w1 = *(const f32x4*)(wp + FF2), w2 = *(const f32x4*)(wp + 2 * FF2), bb = *(const f32x4*)(bp0);
        const f32x4 pp = dpp4(uu[3], true), nn = dpp4(uu[0], false); const f32x4 z = {0.f, 0.f, 0.f, 0.f};
#pragma unroll
        for (int m = 0; m < 4; ++m) { const f32x4 vp = first[m] ? z : (m == 0 ? pp : uu[m == 0 ? 0 : m - 1]), vn = last[m] ? z : (m == 3 ? nn : uu[m == 3 ? 3 : m + 1]);
            o[m] = vp * w0 + (uu[m] * w1 + (vn * w2 + bb)); }
    }
    __device__ __forceinline__ void operator()(const f32x4 (&acc)[2][2][4][2], const Unit& u, int wr, int wc, int fr, int fq) const {
        const int nr = (int)nrows;
#pragma unroll
        for (int ai = 0; ai < 2; ++ai) {
            const int tok0 = 62 * (4 * u.pm + 2 * ai + wr) - 1 + 4 * fr;
            float rs[4]; int rr[4]; bool first[4], last[4];
#pragma unroll
            for (int m = 0; m < 4; ++m) { const int tok = tok0 + m; int tc = tok < 0 ? 0 : tok; tc = tc > ROWS - 1 ? ROWS - 1 : tc; rs[m] = rstd16(ssq, tc); rr[m] = mod_row(tc);
                const int sp = tok < LAT ? (tok & 2047) : (tok & 255); first[m] = sp == 0; last[m] = sp == (tok < LAT ? 2047 : 255); }
#pragma unroll
            for (int n = 0; n < 2; ++n) {
                const int ch0 = u.pn * 128 + wc * 32 + n * 16 + 4 * fq, colv = u.pn * BM + wc * 32 + n * 16 + 4 * fq;
                f32x4 sg[4], av[4];
                conv_block(sg, acc, ai, 1, n, cw + FF + ch0, cb + FF + ch0, rs, rr, first, last, colv);
#pragma unroll
                for (int m = 0; m < 4; ++m)
#pragma unroll
                    for (int e = 0; e < 4; ++e) sg[m][e] = sg[m][e] * fast_sigmoid(sg[m][e]);
                asm volatile("" : "+v"(sg[0]), "+v"(sg[1]), "+v"(sg[2]), "+v"(sg[3]));
                conv_block(av, acc, ai, 0, n, cw + ch0, cb + ch0, rs, rr, first, last, colv);
#pragma unroll
                for (int m = 0; m < 4; ++m) { const int tok = tok0 + m, i = 4 * fr + m; const f32x4 o = av[m] * sg[m];
                    if (i >= 1 && i <= 62 && tok < nr) { u32x2 w; w.x = cvt_pk_bf16(o[0], o[1]); w.y = cvt_pk_bf16(o[2], o[3]); *(u32x2*)(G + (size_t)tok * FF + ch0) = w; } }
                asm volatile("" ::: "memory");
            }
        }
    } };
struct OrderIn1 { pg8::StaticOrder lat; int G, c;
    __device__ void init(int G_, int c_) { lat.init(LAT, HGN, G_, c_); G = G_; c = c_; }
    __device__ bool next(int i, Unit& u) const { if (lat.next(i, u)) return true; const long L = (long)i * G + c - lat.nwg; if (L < 0 || L >= 96) return false; u.pm = 64 + (int)(L / 12); u.pn = 4 + (int)(L % 12); return true; }
    __device__ __forceinline__ void a_ready(const Unit&) const {}
    __device__ __forceinline__ void done(const Unit&) const {} };
}

__device__ __forceinline__ void ph_rope(Frame& F) {
    for (int idx = F.gt; idx < ROWS * 512; idx += F.NGT) { const int row = idx >> 9, pi = idx & 511;
        const int col = (pi >> 4) * 32 + (pi & 15); const int axis = (col >> 5) & 1, f = col & 15;
        bf16_t* p = F.P0() + (size_t)row * EVN + col;
        float x1 = bf2f(p[0]), x2 = bf2f(p[16]);
        if (row < LAT) { const int t = row & 2047; const int pos = axis == 0 ? (t >> 6) : (t & 63); const float c = F.rope()[pos * 16 + f], s = F.rope()[1024 + pos * 16 + f];
            const float o1 = x1 * c - x2 * s, o2 = x2 * c + x1 * s; x1 = o1; x2 = o2; }
        if (col < 512) { x1 *= QSCALE; x2 *= QSCALE; }
        p[0] = f2bf(x1); p[16] = f2bf(x2); }
}
__device__ __forceinline__ void ph_attn_naive(Frame& F) {
    const bf16_t* P = F.P0();
    for (int it = F.gw; it < (ROWS / 64) * 8; it += F.NGW) {
        const int qb = __builtin_amdgcn_readfirstlane(it >> 3), hm = __builtin_amdgcn_readfirstlane(it & 7), h = hm >> 1, m = hm & 1; const int row = qb * 64 + F.lane;
        const bool lat = (qb * 64) < LAT; const int b = lat ? (qb * 64) >> 11 : (qb * 64 - LAT) >> 8;
        float q[64]; { const bf16_t* qp = P + (size_t)row * EVN + h * 128 + m * 64;
#pragma unroll
            for (int d = 0; d < 64; ++d) q[d] = bf2f(qp[d]); }
        float o[128];
#pragma unroll
        for (int d = 0; d < 128; ++d) o[d] = 0.f;
        float mx = -1e30f, l = 0.f; const int nkeys = lat ? 2304 : 256;
        for (int j = 0; j < nkeys; ++j) {
            const int krow = j < 256 ? LAT + b * 256 + j : b * 2048 + (j - 256);
            const bf16_t* kp = P + (size_t)krow * EVN + 512 + h * 128 + m * 64; const bf16_t* vp = P + (size_t)krow * EVN + 1024 + h * 128;
            float s = 0.f;
#pragma unroll
            for (int d = 0; d < 64; ++d) s += q[d] * bf2f(kp[d]);
            const float mn = fmaxf(mx, s), alpha = exp2f(mx - mn), p = exp2f(s - mn); l = l * alpha + p; mx = mn;
#pragma unroll
            for (int d = 0; d < 128; ++d) o[d] = o[d] * alpha + p * bf2f(vp[d]);
        }
        const float il = 1.f / l; bf16_t* op = F.ON() + (((size_t)row * 4 + h) * 2 + m) * 128;
#pragma unroll
        for (int d = 0; d < 128; ++d) op[d] = f2bf(o[d] * il);
    }
}
__device__ __forceinline__ void ph_readout0(Frame& F) {
    const float lam = F.misc()[0];
    for (int w = F.gw; w < ROWS * 4; w += F.NGW) { const int row = w >> 2, h = w & 3, lane = F.lane;
        const bf16_t* p = F.ON() + ((size_t)row * 4 + h) * 256;
        const float a = bf2f(p[lane]) - lam * bf2f(p[128 + lane]), b = bf2f(p[64 + lane]) - lam * bf2f(p[192 + lane]);
        const float rstd = rsqrtf(wave_sum(a * a + b * b) * (1.f / 128.f) + EPS);
        F.A1()[(size_t)row * D + h * 128 + lane] = f2bf(a * rstd * F.misc()[64 + h * 128 + lane]);
        F.A1()[(size_t)row * D + h * 128 + 64 + lane] = f2bf(b * rstd * F.misc()[64 + h * 128 + 64 + lane]); }
}
__device__ __forceinline__ void ph_pool_d(Frame& F) {
    const bf16_t* P = F.P0();
    for (int idx = F.gt; idx < ROWS * 512; idx += F.NGT) { const int row = idx >> 9, c = idx & 511, g = c >> 7, w = 2 << g;
        const int T = row < LAT ? 2048 : 256, t = row < LAT ? (row & 2047) : ((row - LAT) & 255), base = row - t;
        int lo = t - w / 2; if (lo < 0) lo = 0; int hi = t + w - w / 2; if (hi > T) hi = T;
        float s = 0.f; for (int tt = lo; tt < hi; ++tt) s += bf2f(P[(size_t)(base + tt) * EVN + 1536 + c]);
        F.A1()[(size_t)row * D + 512 + c] = f2bf(s / (float)(hi - lo) - bf2f(P[(size_t)row * EVN + 1536 + c])); }
}
namespace att {
using bf16x8 = __attribute__((ext_vector_type(8))) short;
using s16x4  = __attribute__((ext_vector_type(4))) short;
using f32x16 = __attribute__((ext_vector_type(16))) float;
using u32x4  = __attribute__((ext_vector_type(4))) unsigned;
constexpr int QBLK = 32, KVBLK = 64, LDP = EVN;
constexpr int SHM_V = 16384, SHM_K = 8192, L_V = 0, L_K = 2 * SHM_V, L_WS = L_K + 2 * SHM_K, L_ST = L_WS + 2048, L_END = L_ST + 8 * 8192;
constexpr float THR2 = 8.f;
#define KSWZ64(row, colB) ((row) * 128 + ((colB) ^ (((row) & 7) << 4)))
#define ASBAR() __builtin_amdgcn_sched_barrier(0)
__device__ __forceinline__ int crow(int r, int hi) { return (r & 3) + 8 * (r >> 2) + 4 * hi; }
__device__ __forceinline__ unsigned cvtpk(float lo, float hi) { unsigned r; asm volatile("v_cvt_pk_bf16_f32 %0, %1, %2" : "=v"(r) : "v"(lo), "v"(hi)); return r; }
__device__ __forceinline__ void partialSM(f32x16& p0, f32x16& p1, float& m_reg, float& mn, float& alpha) {
  float pmax = p0[0];
#pragma unroll
  for (int r = 1; r < 16; ++r) pmax = fmaxf(pmax, p0[r]);
#pragma unroll
  for (int r = 0; r < 16; ++r) pmax = fmaxf(pmax, p1[r]);
  { auto rr = __builtin_amdgcn_permlane32_swap(__float_as_uint(pmax), __float_as_uint(pmax), false, false); pmax = fmaxf(__uint_as_float(rr[0]), __uint_as_float(rr[1])); }
  if (__builtin_expect(__all(pmax - m_reg <= THR2), 1)) { mn = m_reg; alpha = 1.f; }
  else { mn = fmaxf(m_reg, pmax); alpha = __builtin_amdgcn_exp2f(m_reg - mn); m_reg = mn; }
#pragma unroll
  for (int r = 0; r < 16; ++r) p0[r] -= mn;
#pragma unroll
  for (int r = 0; r < 16; ++r) p1[r] -= mn;
#pragma unroll
  for (int r = 0; r < 16; ++r) p0[r] = __builtin_amdgcn_exp2f(p0[r]);
}
__device__ __forceinline__ void finishSM(f32x16& p0, f32x16& p1, float alpha, float& l_reg, bf16x8& pa0, bf16x8& pa1, bf16x8& pa2, bf16x8& pa3) {
#pragma unroll
  for (int r = 0; r < 16; ++r) p1[r] = __builtin_amdgcn_exp2f(p1[r]);
  float ps = 0;
#pragma unroll
  for (int r = 0; r < 16; ++r) ps += p0[r];
#pragma unroll
  for (int r = 0; r < 16; ++r) ps += p1[r];
  { auto rr = __builtin_amdgcn_permlane32_swap(__float_as_uint(ps), __float_as_uint(ps), false, false); ps = __uint_as_float(rr[0]) + __uint_as_float(rr[1]); }
  l_reg = l_reg * alpha + ps;
#define PK4(P, BASE, OUT) do { unsigned a0 = cvtpk(P[BASE + 0], P[BASE + 1]), a1 = cvtpk(P[BASE + 2], P[BASE + 3]);   \
    unsigned b0 = cvtpk(P[BASE + 4], P[BASE + 5]), b1 = cvtpk(P[BASE + 6], P[BASE + 7]);                              \
    auto r0 = __builtin_amdgcn_permlane32_swap(a0, b0, false, false); auto r1 = __builtin_amdgcn_permlane32_swap(a1, b1, false, false); \
    u32x4 w = {r0[0], r1[0], r0[1], r1[1]}; OUT = *reinterpret_cast<bf16x8*>(&w); } while (0)
  PK4(p0, 0, pa0); PK4(p0, 8, pa1); PK4(p1, 0, pa2); PK4(p1, 8, pa3);
#undef PK4
}
__device__ __forceinline__ void qkt(f32x16& p0, f32x16& p1, const char* Ks, const bf16x8* qr, int r32, int hi) {
  p0 = f32x16{}; p1 = f32x16{};
#pragma unroll
  for (int d0 = 0; d0 < 4; ++d0) { const int cb = (d0 * 16 + hi * 8) * 2;
    const bf16x8 b0 = *reinterpret_cast<const bf16x8*>(Ks + KSWZ64(r32, cb));
    const bf16x8 b1 = *reinterpret_cast<const bf16x8*>(Ks + KSWZ64(32 + r32, cb));
    p0 = __builtin_amdgcn_mfma_f32_32x32x16_bf16(b0, qr[d0], p0, 0, 0, 0);
    p1 = __builtin_amdgcn_mfma_f32_32x32x16_bf16(b1, qr[d0], p1, 0, 0, 0); }
}
__device__ __forceinline__ int v_st(int k, int c) { const int kk = (k & ~0xC) | ((k & 4) << 1) | ((k & 8) >> 1); return ((kk >> 3) * 4 + (c >> 5)) * 512 + ((kk & 7) * 32 + (c & 31)) * 2; }
__device__ __forceinline__ int v_rd_base(int lane) { return ((lane & 3) << 3) | (((lane >> 2) & 3) << 6) | (((lane >> 4) & 1) << 5) | (((lane >> 5) & 1) << 8); }
constexpr int v_rd_off(int d0, int ks, int half) { return d0 * 512 + ks * 4096 + half * 2048; }
template <int OFF> __device__ __forceinline__ s16x4 tr_read(int vb) { s16x4 r; asm volatile("ds_read_b64_tr_b16 %0, %1 offset:%2" : "=&v"(r) : "v"(vb), "i"(OFF) : "memory"); return r; }
template <int D0> __device__ __forceinline__ void pv_one(f32x16& od, int vb, bf16x8 pa0, bf16x8 pa1, bf16x8 pa2, bf16x8 pa3) {
  const s16x4 l0 = tr_read<v_rd_off(D0, 0, 0)>(vb), h0 = tr_read<v_rd_off(D0, 0, 1)>(vb), l1 = tr_read<v_rd_off(D0, 1, 0)>(vb), h1 = tr_read<v_rd_off(D0, 1, 1)>(vb);
  const s16x4 l2 = tr_read<v_rd_off(D0, 2, 0)>(vb), h2 = tr_read<v_rd_off(D0, 2, 1)>(vb), l3 = tr_read<v_rd_off(D0, 3, 0)>(vb), h3 = tr_read<v_rd_off(D0, 3, 1)>(vb);
  asm volatile("s_waitcnt lgkmcnt(0)" ::: "memory"); ASBAR();
#define PK(L, H) (bf16x8){L[0], L[1], L[2], L[3], H[0], H[1], H[2], H[3]}
  od = __builtin_amdgcn_mfma_f32_32x32x16_bf16(pa0, PK(l0, h0), od, 0, 0, 0);
  od = __builtin_amdgcn_mfma_f32_32x32x16_bf16(pa1, PK(l1, h1), od, 0, 0, 0);
  od = __builtin_amdgcn_mfma_f32_32x32x16_bf16(pa2, PK(l2, h2), od, 0, 0, 0);
  od = __builtin_amdgcn_mfma_f32_32x32x16_bf16(pa3, PK(l3, h3), od, 0, 0, 0);
#undef PK
}
__device__ __forceinline__ void pv_d0(f32x16* o, int vb, bf16x8 pa0, bf16x8 pa1, bf16x8 pa2, bf16x8 pa3) {
  pv_one<0>(o[0], vb, pa0, pa1, pa2, pa3); pv_one<1>(o[1], vb, pa0, pa1, pa2, pa3); pv_one<2>(o[2], vb, pa0, pa1, pa2, pa3); pv_one<3>(o[3], vb, pa0, pa1, pa2, pa3);
}
struct KeyRows { int ctx0, lat0; bool isctx; __device__ __forceinline__ int operator()(int t) const { return (isctx || t < 4) ? ctx0 + 64 * t : lat0 + 64 * (t - 4); } };
__device__ __forceinline__ void attn_map(const bf16_t* __restrict__ Pq, const bf16_t* __restrict__ Pk, const bf16_t* __restrict__ Pv, const KeyRows kr, int NT, char* lds, f32x16 (&o)[4], float& l_out) {
  int tid_ = threadIdx.x; asm volatile("" : "+v"(tid_));
  const int tid = tid_, wid = tid >> 6, lane = tid & 63, r32 = lane & 31, hi = lane >> 5;
  char* V_lds = lds + L_V; char* K_lds = lds + L_K;
  float* wsf = (float*)(lds + L_WS) + wid * 64; float* al_l = wsf + 32;
  float m_reg = -1e30f, l_reg = 0; bf16x8 qr[4];
#pragma unroll
  for (int d = 0; d < 4; ++d) o[d] = f32x16{};
  const bf16_t* Qw = Pq + (long)(wid * QBLK + r32) * LDP + hi * 8;
#pragma unroll
  for (int d0 = 0; d0 < 4; ++d0) qr[d0] = *reinterpret_cast<const bf16x8*>(Qw + d0 * 16);
  const int sr = tid >> 4, sc = (tid & 15) * 8, vst0 = v_st(sr, sc), vst1 = v_st(32 + sr, sc);
  const int kr_ = tid >> 3, kc = (tid & 7) * 8, kst = KSWZ64(kr_, kc * 2);
  const int vb0 = (int)(uintptr_t)V_lds + v_rd_base(lane);
  struct { bf16x8 vs0, vs1, ks0; } sr_[1];
#define SLOAD(i, t) do { const long k0_ = kr(t); sr_[i].vs0 = *reinterpret_cast<const bf16x8*>(&Pv[(k0_ + sr) * LDP + sc]); sr_[i].vs1 = *reinterpret_cast<const bf16x8*>(&Pv[(k0_ + 32 + sr) * LDP + sc]); \
    sr_[i].ks0 = *reinterpret_cast<const bf16x8*>(&Pk[(k0_ + kr_) * LDP + kc]); } while (0)
#define SWRITE(b, i) do { *(bf16x8*)(V_lds + (b) * SHM_V + vst0) = sr_[i].vs0; *(bf16x8*)(V_lds + (b) * SHM_V + vst1) = sr_[i].vs1; *(bf16x8*)(K_lds + (b) * SHM_K + kst) = sr_[i].ks0; } while (0)
#define SWAIT() asm volatile("s_waitcnt vmcnt(0)" ::: "memory")
#define RESC(a) do { if (__any((a) < 1.f)) { if (hi == 0) al_l[r32] = (a); asm volatile("s_waitcnt lgkmcnt(0)" ::: "memory"); \
    _Pragma("unroll") for (int d = 0; d < 4; ++d) _Pragma("unroll") for (int r = 0; r < 16; ++r) o[d][r] *= al_l[crow(r, hi)]; } } while (0)
  f32x16 pA0, pA1, pB0, pB1; float mnA, mnB, alA, alB; bf16x8 pa0, pa1, pa2, pa3;
  constexpr int SE = 0, SO = 0;
  SLOAD(SE, 0); asm volatile("s_waitcnt vmcnt(0)" ::: "memory"); SWRITE(0, SE); __syncthreads();
  qkt(pA0, pA1, K_lds, qr, r32, hi); partialSM(pA0, pA1, m_reg, mnA, alA);
  SLOAD(SO, 1);
  SWAIT(); SWRITE(1, SO); __syncthreads();
  for (int j = 1; j + 1 < NT; j += 2) {
    ASBAR(); qkt(pB0, pB1, K_lds + SHM_K, qr, r32, hi);
    finishSM(pA0, pA1, alA, l_reg, pa0, pa1, pa2, pa3); ASBAR();
    SLOAD(SO, j + 1); ASBAR();
    pv_d0(o, vb0, pa0, pa1, pa2, pa3); partialSM(pB0, pB1, m_reg, mnB, alB);
    __syncthreads(); SWAIT(); SWRITE(0, SE);
    RESC(alB); __syncthreads();
    ASBAR(); qkt(pA0, pA1, K_lds, qr, r32, hi);
    finishSM(pB0, pB1, alB, l_reg, pa0, pa1, pa2, pa3); ASBAR();
    SLOAD(SE, j + 2); ASBAR();
    pv_d0(o, vb0 + SHM_V, pa0, pa1, pa2, pa3); partialSM(pA0, pA1, m_reg, mnA, alA);
    __syncthreads(); SWAIT(); SWRITE(1, SO);
    RESC(alA); __syncthreads();
  }
  ASBAR(); qkt(pB0, pB1, K_lds + SHM_K, qr, r32, hi);
  finishSM(pA0, pA1, alA, l_reg, pa0, pa1, pa2, pa3); ASBAR();
  pv_d0(o, vb0, pa0, pa1, pa2, pa3); partialSM(pB0, pB1, m_reg, mnB, alB);
  __syncthreads(); RESC(alB);
  finishSM(pB0, pB1, alB, l_reg, pa0, pa1, pa2, pa3); ASBAR();
  pv_d0(o, vb0 + SHM_V, pa0, pa1, pa2, pa3);
  l_out = l_reg;
#undef SLOAD
#undef SWRITE
#undef SWAIT
#undef RESC
}
__device__ __forceinline__ void attn_unit(const bf16_t* P0, int qrow0, int h, int ctx0, int lat0, bool isctx, float lam, const float* gain, bf16_t* A1, char* lds) {
  int tid_ = threadIdx.x; asm volatile("" : "+v"(tid_));
  const int tid = tid_, wid = tid >> 6, lane = tid & 63, r32 = lane & 31, hi = lane >> 5;
  float* wsf = (float*)(lds + L_WS) + wid * 64;
  bf16_t* stash = (bf16_t*)(lds + L_ST + wid * 8192);
  const KeyRows kr{ctx0, lat0, isctx}; const int NT = isctx ? 4 : 36;
  f32x16 o[4]; float l_reg;
  attn_map(P0 + (long)qrow0 * LDP + h * 128, P0 + 512 + h * 128, P0 + 1024 + h * 128, kr, NT, lds, o, l_reg);
  if (hi == 0) wsf[r32] = l_reg; asm volatile("s_waitcnt lgkmcnt(0)" ::: "memory");
#pragma unroll
  for (int r = 0; r < 16; ++r) { const float rl = __builtin_amdgcn_rcpf(wsf[crow(r, hi)]);
#pragma unroll
    for (int d0 = 0; d0 < 4; ++d0) stash[crow(r, hi) * 128 + d0 * 32 + r32] = f2bf(o[d0][r] * rl); }
  asm volatile("s_waitcnt lgkmcnt(0)" ::: "memory");
  __syncthreads();
  attn_map(P0 + (long)qrow0 * LDP + h * 128 + 64, P0 + 512 + h * 128 + 64, P0 + 1024 + h * 128, kr, NT, lds, o, l_reg);
  if (hi == 0) wsf[r32] = l_reg; asm volatile("s_waitcnt lgkmcnt(0)" ::: "memory");
  float ss[16];
#pragma unroll
  for (int r = 0; r < 16; ++r) { const float rl = lam * __builtin_amdgcn_rcpf(wsf[crow(r, hi)]); float t = 0.f;
#pragma unroll
    for (int d0 = 0; d0 < 4; ++d0) { const float v = bf2f(stash[crow(r, hi) * 128 + d0 * 32 + r32]) - o[d0][r] * rl; o[d0][r] = v; t += v * v; }
#pragma unroll
    for (int off = 1; off < 32; off <<= 1) t += __shfl_xor(t, off);
    ss[r] = rsqrtf(t * (1.f / 128.f) + EPS); }
#pragma unroll
  for (int d0 = 0; d0 < 4; ++d0) { const float g = gain[h * 128 + d0 * 32 + r32];
#pragma unroll
    for (int r = 0; r < 16; ++r) stash[crow(r, hi) * 128 + d0 * 32 + r32] = f2bf(o[d0][r] * ss[r] * g); }
  asm volatile("s_waitcnt lgkmcnt(0)" ::: "memory");
  bf16_t* Ow = A1 + (long)(qrow0 + wid * QBLK) * D + h * 128;
#pragma unroll
  for (int i = 0; i < 8; ++i) { const int row = i * 4 + (lane >> 4), ch = lane & 15; const u32x4 v = *(const u32x4*)(stash + row * 128 + ch * 8); *(u32x4*)(Ow + (long)row * D + ch * 8) = v; }
  asm volatile("s_waitcnt lgkmcnt(0)" ::: "memory");
  __syncthreads();
}
#undef KSWZ64
#undef ASBAR
}
__device__ __forceinline__ void ph_attn_mk(Frame& F) {
    const float lam = F.misc()[0]; const float* gain = F.misc() + 64;
    for (int u = blockIdx.x; u < 288; u += gridDim.x) {
        if (u < 256) { const int bh = u & 31, qb = u >> 5, b = bh >> 2, h = bh & 3; att::attn_unit(F.P0(), b * 2048 + qb * 256, h, LAT + b * 256, b * 2048, false, lam, gain, F.A1(), (char*)F.lds); }
        else { const int bh = u - 256, b = bh >> 2, h = bh & 3; att::attn_unit(F.P0(), LAT + b * 256, h, LAT + b * 256, 0, true, lam, gain, F.A1(), (char*)F.lds); }
    }
}
__device__ __forceinline__ void ph_convgate(Frame& F, int l, int rowBase, int rowBeg, int rowEnd) {
    const float* cw = F.conv_w() + (size_t)l * 3 * FF2; const float* cb = F.conv_b() + (size_t)l * FF2;
    const long n = (long)(rowEnd - rowBeg) * FF;
    for (long idx = F.gt; idx < n; idx += F.NGT) { const int row = rowBeg + (int)(idx / FF), ch = (int)(idx % FF);
        const int T = row < LAT ? 2048 : 256, t = row < LAT ? (row & 2047) : ((row - LAT) & 255);
        const int na = (ch >> 7) * 256 + (ch & 127), ng = na + 128;
        const bf16_t* u = F.UCH() + (size_t)(row - rowBase) * FF2;
        float a = bf2f(u[na]) * cw[FF2 + ch] + cb[ch], gt = bf2f(u[ng]) * cw[FF2 + FF + ch] + cb[FF + ch];
        if (t > 0) { a += bf2f(u[na - FF2]) * cw[ch]; gt += bf2f(u[ng - FF2]) * cw[FF + ch]; }
        if (t < T - 1) { a += bf2f(u[na + FF2]) * cw[2 * FF2 + ch]; gt += bf2f(u[ng + FF2]) * cw[2 * FF2 + FF + ch]; }
        F.G()[(size_t)row * FF + ch] = f2bf(a * silu_f(gt)); }
}
__device__ __forceinline__ void ph_scan_naive(Frame& F, int dir) {
    if ((int)blockIdx.x * 4 >= 64) return;
    const int vb = blockIdx.x * 4 + (F.tid >> 7), d = F.tid & 127;
    LAS float* qs = (LAS float*)(F.lds + (F.tid >> 7) * 1536); LAS float* fs = qs + 128; LAS float* ks = qs + 256;
    const int b = vb >> 3, h = vb & 7;
    float S[128];
#pragma unroll
    for (int c = 0; c < 128; ++c) S[c] = 0.f;
    const f16_t* L = dir ? F.LB1() : F.LF1();
    for (int step = 0; step < 2304; ++step) {
        const bool isctx = step < 256; const int t = isctx ? (dir ? 255 - step : step) : (dir ? 2047 - (step - 256) : (step - 256));
        const int row = isctx ? LAT + b * 256 + t : b * 2048 + t; const size_t o = (size_t)row * D + h * 128;
        const float f = (float)L[o + d]; fs[d] = f; ks[d] = 1.f - f; qs[d] = isctx ? 0.f : bf2f(F.Q1()[o + d]);
        const float v = bf2f(F.V1()[o + d]);
        __syncthreads();
        float acc = 0.f;
#pragma unroll
        for (int c = 0; c < 128; ++c) { S[c] = fs[c] * S[c] + ks[c] * v; acc += qs[c] * S[c]; }
        if (!isctx) (dir ? F.OB() : F.OF())[o + d] = f2bf(acc);
        __syncthreads();
    }
}
namespace scn {
using bf16x8 = __attribute__((ext_vector_type(8))) short;
using f32x16 = __attribute__((ext_vector_type(16))) float;
constexpr int L_Q = 0, L_K = 16384, L_KT = 32768, L_VT = 49152, L_ST = 57344, L_AM = 73728, L_X = 81920, L_VEC = L_X + 36864, L_END = L_VEC + 2048;
constexpr int X_T = 0, X_PX = 16384, X_PT = 32768, X_TOT = 34816;
__device__ __forceinline__ int sw256(int row, int byte) { return row * 256 + (((byte) & ~15) ^ ((row & 7) << 4)) + (byte & 15); }
__device__ __forceinline__ int sw128(int row, int byte) { return row * 128 + (((byte) & ~15) ^ ((row & 7) << 4)) + (byte & 15); }
__device__ __forceinline__ int crow(int r, int hi) { return (r & 3) + 8 * (r >> 2) + 4 * hi; }
__device__ __forceinline__ unsigned pkbf(float lo, float hi) { unsigned r; asm volatile("v_cvt_pk_bf16_f32 %0, %1, %2" : "=v"(r) : "v"(lo), "v"(hi)); return r; }
__device__ __forceinline__ void scan_unit(const bf16_t* __restrict__ Q1, const bf16_t* __restrict__ V1, const f16_t* __restrict__ Fg, bf16_t* __restrict__ Od, int b, int h, int dir, int half, char* lds) {
  int tid_ = threadIdx.x; asm volatile("" : "+v"(tid_));
  const int tid = tid_, lane = tid & 63, r32 = lane & 31, hi = lane >> 5; const int wid = __builtin_amdgcn_readfirstlane(tid >> 6);
  const int seg = tid >> 4, cg = tid & 15, tv = tid >> 3, dch = tid & 7, t0 = 2 * seg, t1 = t0 + 1;
  float* XF = (float*)(lds + L_X); float* VEC = (float*)(lds + L_VEC);
  const int colh = h * 128;
  for (int i = tid; i < 8192 / 16; i += 512) *(uint4*)(lds + L_AM + i * 16) = make_uint4(0u, 0u, 0u, 0u);
  f32x16 S0 = f32x16{}, S1 = f32x16{};
  uint4 rf0, rf1, rq0, rq1, rv;
#define CBASE(st) ((st) < 4 ? LAT + b * 256 + 64 * (dir ? 3 - (st) : (st)) : b * 2048 + 64 * (dir ? 35 - (st) : (st) - 4))
#define GROW(cb_, t) ((long)(cb_) + (dir ? 63 - (t) : (t)))
#define PREFETCH(st) do { const int cb_ = CBASE(st); rf0 = *(const uint4*)(Fg + GROW(cb_, t0) * D + colh + 8 * cg); rf1 = *(const uint4*)(Fg + GROW(cb_, t1) * D + colh + 8 * cg); \
    if ((st) >= 4) { rq0 = *(const uint4*)(Q1 + GROW(cb_, t0) * D + colh + 8 * cg); rq1 = *(const uint4*)(Q1 + GROW(cb_, t1) * D + colh + 8 * cg); } \
    rv = *(const uint4*)(V1 + GROW(cb_, tv) * D + colh + half * 64 + 8 * dch); } while (0)
  PREFETCH(0);
#pragma unroll 1
  for (int step = 0; step < 36; ++step) {
    const bool isctx = step < 4; const int cbase = CBASE(step);
    float fa[8], fb[8], p2[8];
    { typedef _Float16 h8 __attribute__((ext_vector_type(8))); const h8 a = __builtin_bit_cast(h8, rf0), c = __builtin_bit_cast(h8, rf1);
#pragma unroll
      for (int j = 0; j < 8; ++j) { fa[j] = (float)a[j]; fb[j] = (float)c[j]; p2[j] = fa[j] * fb[j]; } }
    __syncthreads();
    *(float4*)(XF + X_T / 4 + seg * 128 + 8 * cg) = make_float4(p2[0], p2[1], p2[2], p2[3]); *(float4*)(XF + X_T / 4 + seg * 128 + 8 * cg + 4) = make_float4(p2[4], p2[5], p2[6], p2[7]);
    __syncthreads();
    { const int c = tid & 127, part = tid >> 7; float pt = 1.f;
#pragma unroll
      for (int q = 0; q < 8; ++q) pt *= XF[X_T / 4 + (8 * part + q) * 128 + c];
      XF[X_PT / 4 + part * 128 + c] = pt; }
    __syncthreads();
    { const int c = tid & 127, part = tid >> 7; float base = 1.f;
#pragma unroll
      for (int q = 0; q < 3; ++q) if (q < part) base *= XF[X_PT / 4 + q * 128 + c];
#pragma unroll
      for (int q = 0; q < 8; ++q) { XF[X_PX / 4 + (8 * part + q) * 128 + c] = base; base *= XF[X_T / 4 + (8 * part + q) * 128 + c]; }
      if (part == 3) XF[X_TOT / 4 + c] = base; }
    __syncthreads();
    { float px[8], p31[8], ip31[8];
      { const float4 a = *(const float4*)(XF + X_PX / 4 + seg * 128 + 8 * cg), c = *(const float4*)(XF + X_PX / 4 + seg * 128 + 8 * cg + 4);
        px[0] = a.x; px[1] = a.y; px[2] = a.z; px[3] = a.w; px[4] = c.x; px[5] = c.y; px[6] = c.z; px[7] = c.w;
        const float4 e = *(const float4*)(XF + X_PX / 4 + 16 * 128 + 8 * cg), g = *(const float4*)(XF + X_PX / 4 + 16 * 128 + 8 * cg + 4);
        p31[0] = e.x; p31[1] = e.y; p31[2] = e.z; p31[3] = e.w; p31[4] = g.x; p31[5] = g.y; p31[6] = g.z; p31[7] = g.w; }
      float q0[8], q1[8];
      if (!isctx) { const unsigned* a = (const unsigned*)&rq0; const unsigned* c = (const unsigned*)&rq1;
#pragma unroll
        for (int j = 0; j < 4; ++j) { q0[2 * j] = __uint_as_float(a[j] << 16); q0[2 * j + 1] = __uint_as_float(a[j] & 0xffff0000u); q1[2 * j] = __uint_as_float(c[j] << 16); q1[2 * j + 1] = __uint_as_float(c[j] & 0xffff0000u); } }
      else {
#pragma unroll
        for (int j = 0; j < 8; ++j) { q0[j] = 0.f; q1[j] = 0.f; } }
      float qa[8], qb[8], ka[8], kb[8];
#pragma unroll
      for (int j = 0; j < 8; ++j) { p31[j] = fmaxf(p31[j], 1e-30f); ip31[j] = __builtin_amdgcn_rcpf(p31[j]);
        const float Pa = px[j] * fa[j], Pb = px[j] * p2[j];
        qa[j] = q0[j] * (Pa * ip31[j]); qb[j] = q1[j] * (Pb * ip31[j]);
        ka[j] = (1.f - fa[j]) * (p31[j] * __builtin_amdgcn_rcpf(fmaxf(Pa, 1e-30f))); kb[j] = (1.f - fb[j]) * (p31[j] * __builtin_amdgcn_rcpf(fmaxf(Pb, 1e-30f))); }
      *(uint4*)(lds + L_Q + sw256(t0, 16 * cg)) = make_uint4(pkbf(qa[0], qa[1]), pkbf(qa[2], qa[3]), pkbf(qa[4], qa[5]), pkbf(qa[6], qa[7]));
      *(uint4*)(lds + L_Q + sw256(t1, 16 * cg)) = make_uint4(pkbf(qb[0], qb[1]), pkbf(qb[2], qb[3]), pkbf(qb[4], qb[5]), pkbf(qb[6], qb[7]));
      *(uint4*)(lds + L_K + sw256(t0, 16 * cg)) = make_uint4(pkbf(ka[0], ka[1]), pkbf(ka[2], ka[3]), pkbf(ka[4], ka[5]), pkbf(ka[6], ka[7]));
      *(uint4*)(lds + L_K + sw256(t1, 16 * cg)) = make_uint4(pkbf(kb[0], kb[1]), pkbf(kb[2], kb[3]), pkbf(kb[4], kb[5]), pkbf(kb[6], kb[7]));
#pragma unroll
      for (int j = 0; j < 8; ++j) *(unsigned*)(lds + L_KT + sw128(8 * cg + j, 4 * seg)) = pkbf(ka[j], kb[j]);
      { const unsigned short* vv = (const unsigned short*)&rv;
#pragma unroll
        for (int j = 0; j < 8; ++j) *(unsigned short*)(lds + L_VT + sw128(8 * dch + j, 2 * tv)) = vv[j]; }
      if (seg == 0) {
#pragma unroll
        for (int j = 0; j < 8; ++j) { const float tot = XF[X_TOT / 4 + 8 * cg + j]; VEC[8 * cg + j] = tot; VEC[128 + 8 * cg + j] = tot * ip31[j]; } }
    }
    if (wid >= 4) { const int cb = wid - 4;
#pragma unroll
      for (int r4 = 0; r4 < 4; ++r4) { const int c0 = 32 * cb + 8 * r4 + 4 * hi; const float4 pv = *(const float4*)(XF + X_PX / 4 + 16 * 128 + c0);
        const float g0 = fmaxf(pv.x, 1e-30f), g1 = fmaxf(pv.y, 1e-30f), g2 = fmaxf(pv.z, 1e-30f), g3 = fmaxf(pv.w, 1e-30f);
        *(uint2*)(lds + L_ST + sw256(r32, 2 * c0)) = make_uint2(pkbf(S0[4 * r4] * g0, S0[4 * r4 + 1] * g1), pkbf(S0[4 * r4 + 2] * g2, S0[4 * r4 + 3] * g3));
        *(uint2*)(lds + L_ST + sw256(32 + r32, 2 * c0)) = make_uint2(pkbf(S1[4 * r4] * g0, S1[4 * r4 + 1] * g1), pkbf(S1[4 * r4 + 2] * g2, S1[4 * r4 + 3] * g3)); } }
    if (step + 1 < 36) PREFETCH(step + 1);
    __syncthreads();
    if (!isctx && wid < 3) { const int sb = wid == 2 ? 1 : 0, tb = wid == 0 ? 0 : 1; f32x16 acc = f32x16{};
#pragma unroll
      for (int ks = 0; ks < 8; ++ks) { const bf16x8 a = *(const bf16x8*)(lds + L_K + sw256(32 * sb + r32, (16 * ks + 8 * hi) * 2)), bq = *(const bf16x8*)(lds + L_Q + sw256(32 * tb + r32, (16 * ks + 8 * hi) * 2));
        acc = __builtin_amdgcn_mfma_f32_32x32x16_bf16(a, bq, acc, 0, 0, 0); }
      const int t = 32 * tb + r32;
#pragma unroll
      for (int r4 = 0; r4 < 4; ++r4) { const int s0 = 32 * sb + 8 * r4 + 4 * hi;
        const float x0 = (s0 + 0 <= t) ? acc[4 * r4 + 0] : 0.f, x1 = (s0 + 1 <= t) ? acc[4 * r4 + 1] : 0.f, x2 = (s0 + 2 <= t) ? acc[4 * r4 + 2] : 0.f, x3 = (s0 + 3 <= t) ? acc[4 * r4 + 3] : 0.f;
        *(uint2*)(lds + L_AM + sw128(t, 2 * s0)) = make_uint2(pkbf(x0, x1), pkbf(x2, x3)); } }
    if (wid >= 4) { const int cb = wid - 4; f32x16 U0 = f32x16{}, U1 = f32x16{};
#pragma unroll
      for (int ks = 0; ks < 4; ++ks) { const bf16x8 a = *(const bf16x8*)(lds + L_KT + sw128(32 * cb + r32, (16 * ks + 8 * hi) * 2));
        const bf16x8 v0 = *(const bf16x8*)(lds + L_VT + sw128(r32, (16 * ks + 8 * hi) * 2)), v1 = *(const bf16x8*)(lds + L_VT + sw128(32 + r32, (16 * ks + 8 * hi) * 2));
        U0 = __builtin_amdgcn_mfma_f32_32x32x16_bf16(a, v0, U0, 0, 0, 0); U1 = __builtin_amdgcn_mfma_f32_32x32x16_bf16(a, v1, U1, 0, 0, 0); }
#pragma unroll
      for (int r = 0; r < 16; ++r) { const int c = 32 * cb + crow(r, hi); const float dec = VEC[c], bco = VEC[128 + c]; S0[r] = dec * S0[r] + bco * U0[r]; S1[r] = dec * S1[r] + bco * U1[r]; } }
    __syncthreads();
    if (!isctx) { const int blk = wid & 3, tb = blk >> 1, db = blk & 1, kp = wid >> 2; f32x16 acc = f32x16{};
      if (kp == 0) {
#pragma unroll
        for (int ks = 0; ks < 4; ++ks) { const bf16x8 a = *(const bf16x8*)(lds + L_AM + sw128(32 * tb + r32, (16 * ks + 8 * hi) * 2)), v = *(const bf16x8*)(lds + L_VT + sw128(32 * db + r32, (16 * ks + 8 * hi) * 2));
          acc = __builtin_amdgcn_mfma_f32_32x32x16_bf16(a, v, acc, 0, 0, 0); }
#pragma unroll
        for (int ks = 0; ks < 2; ++ks) { const bf16x8 a = *(const bf16x8*)(lds + L_Q + sw256(32 * tb + r32, (16 * ks + 8 * hi) * 2)), v = *(const bf16x8*)(lds + L_ST + sw256(32 * db + r32, (16 * ks + 8 * hi) * 2));
          acc = __builtin_amdgcn_mfma_f32_32x32x16_bf16(a, v, acc, 0, 0, 0); }
      } else {
#pragma unroll
        for (int ks = 2; ks < 8; ++ks) { const bf16x8 a = *(const bf16x8*)(lds + L_Q + sw256(32 * tb + r32, (16 * ks + 8 * hi) * 2)), v = *(const bf16x8*)(lds + L_ST + sw256(32 * db + r32, (16 * ks + 8 * hi) * 2));
          acc = __builtin_amdgcn_mfma_f32_32x32x16_bf16(a, v, acc, 0, 0, 0); }
      }
#pragma unroll
      for (int r = 0; r < 16; ++r) XF[(kp * 64 + 32 * tb + crow(r, hi)) * 64 + 32 * db + r32] = acc[r]; }
    __syncthreads();
    if (!isctx) { const float4 a0 = *(const float4*)(XF + tv * 64 + 8 * dch), a1 = *(const float4*)(XF + tv * 64 + 8 * dch + 4), c0 = *(const float4*)(XF + (64 + tv) * 64 + 8 * dch), c1 = *(const float4*)(XF + (64 + tv) * 64 + 8 * dch + 4);
      *(uint4*)(Od + GROW(cbase, tv) * D + colh + half * 64 + 8 * dch) = make_uint4(pkbf(a0.x + c0.x, a0.y + c0.y), pkbf(a0.z + c0.z, a0.w + c0.w), pkbf(a1.x + c1.x, a1.y + c1.y), pkbf(a1.z + c1.z, a1.w + c1.w)); }
  }
  __syncthreads();
#undef CBASE
#undef GROW
#undef PREFETCH
}
}
__device__ __forceinline__ void ph_scan_mk(Frame& F) {
    for (int u = blockIdx.x; u < 256; u += gridDim.x) {
        const int x = u & 7, y = u >> 3, half = y & 1, g = (y >> 1) * 8 + x, dir = g & 1, bh = g >> 1, b = bh >> 3, h = bh & 7;
        scn::scan_unit(F.Q1(), F.V1(), dir ? F.LB1() : F.LF1(), dir ? F.OB() : F.OF(), b, h, dir, half, (char*)F.lds);
    }
}
__device__ __forceinline__ void ph_combine1(Frame& F) {
    for (int w = F.gw; w < LAT * 8; w += F.NGW) { const int row = w >> 3, h = w & 7, lane = F.lane; const size_t o = (size_t)row * D + h * 128;
        const float a = bf2f(F.OF()[o + lane]) + bf2f(F.OB()[o + lane]), b = bf2f(F.OF()[o + 64 + lane]) + bf2f(F.OB()[o + 64 + lane]);
        const float rstd = rsqrtf(wave_sum(a * a + b * b) * (1.f / 128.f) + EPS);
        F.A3()[o + lane] = f2bf(a * rstd * F.hg_norm()[h * 128 + lane] * bf2f(F.GG1()[o + lane]));
        F.A3()[o + 64 + lane] = f2bf(b * rstd * F.hg_norm()[h * 128 + 64 + lane] * bf2f(F.GG1()[o + 64 + lane])); }
}
__device__ __forceinline__ void ph_final(Frame& F) {
    for (int row = F.gw; row < LAT; row += F.NGW) { float* xr = F.out() + (size_t)row * D;
        float4 v[4]; float s = 0.f;
#pragma unroll
        for (int j = 0; j < 4; ++j) { v[j] = *(const float4*)(xr + j * 256 + F.lane * 4); s += (v[j].x * v[j].x + v[j].y * v[j].y) + (v[j].z * v[j].z + v[j].w * v[j].w); }
        const float rstd = rsqrtf(wave_sum(s) * (1.f / D) + EPS);
#pragma unroll
        for (int j = 0; j < 4; ++j) { const float4 g = *(const float4*)(F.final_norm() + j * 256 + F.lane * 4); *(float4*)(xr + j * 256 + F.lane * 4) = make_float4(v[j].x * rstd * g.x, v[j].y * rstd * g.y, v[j].z * rstd * g.z, v[j].w * rstd * g.w); }
    }
}

constexpr int NPHASE = 14;
#ifndef OPT_P2
#define OPT_P2 1
#endif
#ifndef OPT_P4
#define OPT_P4 1
#endif
#ifndef OPT_P6
#define OPT_P6 1
#endif
#ifndef OPT_P7
#define OPT_P7 1
#endif
#ifndef OPT_P10
#define OPT_P10 1
#endif
#ifndef OPT_P5
#define OPT_P5 1
#endif
#ifndef OPT_P11
#define OPT_P11 1
#endif
#ifndef OPT_P3
#define OPT_P3 1
#endif
#ifndef OPT_P8
#define OPT_P8 1
#endif
#ifndef OPT_P12
#define OPT_P12 1
#endif
__global__ void __launch_bounds__(NTHR, 2) mk_fwd(Args args) {
    extern __shared__ __attribute__((aligned(16))) unsigned char lds_raw[];
    Frame F(args);
    F.lds = (LAS unsigned char*)lds_raw;
    F.tid = threadIdx.x; F.lane = F.tid & 63; F.wave = __builtin_amdgcn_readfirstlane(F.tid >> 6);
    F.gw = blockIdx.x * 8 + F.wave; F.NGW = gridDim.x * 8; F.gt = blockIdx.x * NTHR + F.tid; F.NGT = gridDim.x * NTHR;
    unsigned char* ws = args.ws;

    volatile LAS unsigned* MISC = (volatile LAS unsigned*)(F.lds + LDS_MISC);
    if (F.tid < 64) MISC[F.tid] = 0u;
    __syncthreads();
    XcdBarrier bar = xcd_barrier_post((unsigned*)(ws + OFF_CTL) + 1024, MISC + 8);
#define GRID_BAR() xcd_barrier(bar)
    const int lo = args.ph_lo, hi = args.ph_hi;
#define IN(k) (lo <= (k) && (k) < hi)
#define SEAM(k) do { if (IN(k) && IN((k) + 1)) GRID_BAR(); } while (0)

    if (IN(0)) { ph_mods(F); ph_small(F); __syncthreads(); ph_transposes(F); ph_weff(F); }
    SEAM(0);
    if (IN(1)) { ph_bias(F); ph_norm_mod(F); }
    SEAM(1);
    if (IN(2)) {
#if OPT_P2
        { pg8::Gemm g{F.A0(), F.Win0(), ROWS, EVN, 1024, 0}; pg8::StaticOrder S; S.init(ROWS, EVN, (int)gridDim.x, (int)blockIdx.x); mk::EpiStoreMK E{F.P0(), EVN};
          pg8::gemm_phase<mk::EpiStoreMK, pg8::StaticOrder, PG8_ALIGN, PG8_SP2>(F.lds, g, S, E); }
#else
        gemm_naive_phase(F, F.A0(), F.Win0(), EVN, 1024, 0, ROWS, EpiStore{F.P0(), EVN});
#endif
        GRID_BAR(); ph_rope(F); }
    SEAM(2);
    if (IN(3)) {
#if OPT_P3
        ph_attn_mk(F); ph_pool_d(F);
#else
        ph_attn_naive(F); ph_pool_d(F); GRID_BAR(); ph_readout0(F);
#endif
    }
    SEAM(3);
    if (IN(4)) {
#if OPT_P4
        { pg8::Gemm g{F.A1(), F.Wout0(), ROWS, 1024, 1024, 0}; pg8::StaticOrder S; S.init(ROWS, 1024, (int)gridDim.x, (int)blockIdx.x);
          mk::EpiResidMK E{F.x(), F.ctx(), F.out(), F.xc(), F.mods() + 2 * 1024, F.mods() + 4 * 1024, F.A0(), F.ssq()};
          pg8::gemm_phase<mk::EpiResidMK, pg8::StaticOrder, PG8_ALIGN, PG8_SP2>(F.lds, g, S, E); }
#else
        gemm_naive_phase(F, F.A1(), F.Wout0(), 1024, 1024, 0, ROWS, EpiResid{F.x(), F.ctx(), F.out(), F.xc(), F.mods() + 2 * 1024, F.mods() + 4 * 1024, F.A0()}); GRID_BAR(); ph_rowssq(F, ROWS);
#endif
    }
    SEAM(4);
    if (IN(5)) {
#if OPT_P5
        { pg8::Gemm g{F.A0() - 1024, F.Wup0(), ROWS, FF2, 1024, 1}; pg8::StaticOrder S; S.init2((ROWS + 247) / 248, FF2 / 256, (int)gridDim.x, (int)blockIdx.x);
          mk::EpiUpConvMK E{F.ssq(), F.bup(), F.conv_w(), F.conv_b(), F.G(), ROWS};
          pg8::gemm_phase<mk::EpiUpConvMK, pg8::StaticOrder, PG8_ALIGN, PG8_SP2>(F.lds, g, S, E); }
#else
        for (int c0 = 0; c0 < ROWS; c0 += 4608) { const int c1 = c0 + 4608, rb = c0 - 1, re = c1 + 1 > ROWS ? ROWS : c1 + 1;
            gemm_naive_phase(F, F.A0(), F.Wup0(), FF2, 1024, rb, re, EpiUp{F.UCH(), rb, F.ssq(), F.bup()}); GRID_BAR(); ph_convgate(F, 0, rb, c0, c1); if (c1 < ROWS) GRID_BAR(); }
#endif
    }
    SEAM(5);
    if (IN(6)) {
#if OPT_P6
        { pg8::Gemm g{F.G(), F.Wdn0(), ROWS, 1024, FF, 0}; pg8::StaticOrder S; S.init(ROWS, 1024, (int)gridDim.x, (int)blockIdx.x);
          mk::EpiResidMK E{F.out(), F.xc(), F.out(), F.xc(), F.mods() + 5 * 1024, F.mods() + 9 * 6144 + 1 * 1024, F.A0(), F.ssq()};
          pg8::gemm_phase<mk::EpiResidMK, pg8::StaticOrder, PG8_ALIGN, PG8_SP2>(F.lds, g, S, E); }
#else
        gemm_naive_phase(F, F.G(), F.Wdn0(), 1024, FF, 0, ROWS, EpiResid{F.out(), F.xc(), F.out(), F.xc(), F.mods() + 5 * 1024, F.mods() + 9 * 6144 + 1 * 1024, F.A0()}); GRID_BAR(); ph_rowssq(F, ROWS);
#endif
    }
    SEAM(6);
    if (IN(7)) {
#if OPT_P7
        { pg8::Gemm g{F.A0(), F.Win1(), ROWS, HGN, 1024, 0}; mk::OrderIn1 S; S.init((int)gridDim.x, (int)blockIdx.x);
          mk::EpiIn1MK E{F.ssq(), F.bin1(), F.misc() + 1024, F.Q1(), F.GG1(), F.V1(), F.LF1(), F.LB1()};
          pg8::gemm_phase<mk::EpiIn1MK, mk::OrderIn1, PG8_ALIGN, PG8_SP2>(F.lds, g, S, E); }
#else
        gemm_naive_phase(F, F.A0(), F.Win1(), HGN, 1024, 0, ROWS, EpiIn1{F.ssq(), F.bin1(), F.misc() + 1024, F.Q1(), F.GG1(), F.V1(), F.LF1(), F.LB1()});
#endif
    }
    SEAM(7);
    if (IN(8)) {
#if OPT_P8
        ph_scan_mk(F);
#else
        ph_scan_naive(F, 0); ph_scan_naive(F, 1);
#endif
    }
    SEAM(8);
    if (IN(9)) { ph_combine1(F); ph_transposes_l1ffn(F); }
    SEAM(9);
    if (IN(10)) {
        ph_bias_up1(F);
#if OPT_P10
        { pg8::Gemm g{F.A3(), F.Wout1(), LAT, 1024, 1024, 0}; pg8::StaticOrder S; S.init(LAT, 1024, (int)gridDim.x, (int)blockIdx.x);
          mk::EpiResidMK E{F.out(), F.xc(), F.out(), F.xc(), F.mods() + 9 * 6144 + 2 * 1024, F.mods() + 9 * 6144 + 4 * 1024, F.A0(), F.ssq()};
          pg8::gemm_phase<mk::EpiResidMK, pg8::StaticOrder, PG8_ALIGN, PG8_SP2>(F.lds, g, S, E); }
#else
        gemm_naive_phase(F, F.A3(), F.Wout1(), 1024, 1024, 0, LAT, EpiResid{F.out(), F.xc(), F.out(), F.xc(), F.mods() + 9 * 6144 + 2 * 1024, F.mods() + 9 * 6144 + 4 * 1024, F.A0()}); GRID_BAR(); ph_rowssq(F, LAT);
#endif
    }
    SEAM(10);
    if (IN(11)) {
#if OPT_P11
        { pg8::Gemm g{F.A0() - 1024, F.Wup1(), LAT, FF2, 1024, 1}; pg8::StaticOrder S; S.init2((LAT + 247) / 248, FF2 / 256, (int)gridDim.x, (int)blockIdx.x);
          mk::EpiUpConvMK E{F.ssq(), F.bup() + 9 * FF2, F.conv_w() + 3 * FF2, F.conv_b() + FF2, F.G(), LAT};
          pg8::gemm_phase<mk::EpiUpConvMK, pg8::StaticOrder, PG8_ALIGN, PG8_SP2>(F.lds, g, S, E); }
#else
        for (int c0 = 0; c0 < LAT; c0 += 4608) { const int c1 = c0 + 4608 > LAT ? LAT : c0 + 4608, rb = c0 - 1, re = c1 + 1;
            gemm_naive_phase(F, F.A0(), F.Wup1(), FF2, 1024, rb, re, EpiUp{F.UCH(), rb, F.ssq(), F.bup() + 9 * FF2}); GRID_BAR(); ph_convgate(F, 1, rb, c0, c1); if (c1 < LAT) GRID_BAR(); }
#endif
    }
    SEAM(11);
    if (IN(12)) {
#if OPT_P12
        { pg8::Gemm g{F.G(), F.Wdn1(), LAT, 1024, FF, 0}; pg8::StaticOrder S; S.init(LAT, 1024, (int)gridDim.x, (int)blockIdx.x);
          mk::EpiResidMK E{F.out(), F.xc(), F.out(), F.xc(), F.mods() + 9 * 6144 + 5 * 1024, nullptr, nullptr, nullptr};
          pg8::gemm_phase<mk::EpiResidMK, pg8::StaticOrder, PG8_ALIGN, PG8_SP2>(F.lds, g, S, E); }
#else
        gemm_naive_phase(F, F.G(), F.Wdn1(), 1024, FF, 0, LAT, EpiResid{F.out(), F.xc(), F.out(), F.xc(), F.mods() + 9 * 6144 + 5 * 1024, nullptr, nullptr});
#endif
    }
    SEAM(12);
    if (IN(13)) ph_final(F);
}

extern "C" void kernel_launch(void* const* d_in, const int* in_sizes, int n_in, void* d_out, int out_size, void* d_ws, size_t ws_size, hipStream_t st) {
    static int grid = 0;
    if (grid == 0) {
        if (n_in != 24 || ws_size < WS_END || out_size != LAT * D) { fprintf(stderr, "kernel_launch: unexpected shapes (n_in %d, ws %zu, out %d)\n", n_in, ws_size, out_size); grid = -1; return; }
        int dev = 0, cus = 0;
        if (hipGetDevice(&dev) != hipSuccess || hipDeviceGetAttribute(&cus, hipDeviceAttributeMultiprocessorCount, dev) != hipSuccess) { grid = -1; return; }
        if (hipFuncSetAttribute((const void*)mk_fwd, hipFuncAttributeMaxDynamicSharedMemorySize, LDS_BYTES) != hipSuccess) { fprintf(stderr, "kernel_launch: hipFuncSetAttribute failed\n"); grid = -1; return; }
        int per_cu = 0; (void)hipOccupancyMaxActiveBlocksPerMultiprocessor(&per_cu, (const void*)mk_fwd, NTHR, LDS_BYTES); (void)hipGetLastError();
        if (per_cu < 1) fprintf(stderr, "kernel_launch: occupancy query reports %d\n", per_cu);
        grid = cus;
    }
    if (grid < 0) return;
    (void)hipMemsetAsync((char*)d_ws + OFF_CTL, 0, CTL_ZERO_BYTES, st);
    Args a{};
    for (int i = 0; i < 24; ++i) a.in[i] = (const float*)d_in[i];
    a.out = (float*)d_out; a.ws = (unsigned char*)d_ws; a.ph_lo = 0; a.ph_hi = NPHASE;
    hipLaunchKernelGGL(mk_fwd, dim3(grid), dim3(NTHR), LDS_BYTES, st, a);
}
```

```cpp
#include <hip/hip_runtime.h>
#include <cstdint>
#include <cstdio>

typedef unsigned short bf16_t;
typedef _Float16 f16_t;

namespace cfg {
constexpr int D = 1024, BATCH = 8, SEQ = 2048, CTXL = 256;
constexpr int LAT = BATCH * SEQ, CTXR = BATCH * CTXL, ROWS = LAT + CTXR;
constexpr int EVN = 2048, HGN = 5120, FF = 2816, FF2 = 5632;
constexpr float EPS = 1e-6f;
constexpr float QSCALE = 0.125f * 1.4426950408889634f;
constexpr size_t MiB = 1u << 20;
constexpr size_t OFF_CTL = 0, CTL_ZERO_BYTES = 64 * 1024;
constexpr size_t OFF_MODS = 1 * MiB;
constexpr size_t OFF_ROPE = 1 * MiB + 512 * 1024;
constexpr size_t OFF_MISC = OFF_ROPE + 8192;
constexpr size_t OFF_BUP = 2 * MiB;
constexpr size_t OFF_BIN1 = 2 * MiB + 512 * 1024;
constexpr size_t OFF_SSQ = 2 * MiB + 768 * 1024;
constexpr size_t OFF_WIN1 = 4 * MiB, OFF_WOUT1 = 250 * MiB, OFF_WUP1 = 190 * MiB, OFF_WDN1 = 201 * MiB;
constexpr size_t OFF_XC = 32 * MiB + 512 * 1024;
constexpr size_t OFF_A = 41 * MiB;
constexpr size_t OFF_WIN0 = 78 * MiB, OFF_WOUT0 = 82 * MiB, OFF_WUP0 = 84 * MiB, OFF_WDN0 = 95 * MiB;
constexpr size_t OFF_B = 100 * MiB + 512 * 1024;
constexpr size_t OFF_P0 = OFF_B;
constexpr size_t OFF_A1 = OFF_B + 72 * MiB;
constexpr size_t OFF_ON = OFF_A1 + 36 * MiB;
constexpr size_t OFF_G = OFF_B;
constexpr size_t OFF_UCH = OFF_B + 99 * MiB;
constexpr size_t OFF_Q1 = 78 * MiB, OFF_GG1 = 110 * MiB, OFF_V1 = 142 * MiB, OFF_LF1 = 178 * MiB, OFF_LB1 = 214 * MiB;
constexpr size_t OFF_OF = OFF_A, OFF_OB = 4 * MiB;
constexpr size_t OFF_A3 = OFF_Q1;
constexpr size_t WS_END = 256 * MiB;
static_assert(OFF_ON + 36 * MiB <= WS_END && OFF_UCH + (size_t)4610 * 5632 * 2 <= WS_END && OFF_LB1 + 36 * MiB <= OFF_WOUT1 && OFF_WOUT1 + 2 * MiB <= WS_END && OFF_OB + 32 * MiB <= OFF_A, "ws map");
constexpr int NTHR = 512, LDS_BYTES = 147456;
constexpr int LDS_MISC = 140 * 1024;
}
using namespace cfg;

#define GAS __attribute__((address_space(1)))
#define LAS __attribute__((address_space(3)))
__device__ __forceinline__ float bf2f(bf16_t v) { return __uint_as_float((unsigned)v << 16); }
__device__ __forceinline__ bf16_t f2bf(float f) { unsigned u = __float_as_uint(f); return (bf16_t)((u + 0x7fffu + ((u >> 16) & 1u)) >> 16); }
__device__ __forceinline__ unsigned pk2(float lo, float hi) { return (unsigned)f2bf(lo) | ((unsigned)f2bf(hi) << 16); }
__device__ __forceinline__ float silu_f(float x) { return x / (1.f + expf(-x)); }
__device__ __forceinline__ float wave_sum(float v) {
#pragma unroll
    for (int o = 1; o < 64; o <<= 1) v += __shfl_xor(v, o);
    return v;
}
__device__ __forceinline__ int mod_row(int row) { return row < LAT ? (row >> 11) : 8; }
__device__ __forceinline__ float rstd_of(const float* ssq, int row) { const float4* p = (const float4*)(ssq + (size_t)row * 16); float t = 0.f;
#pragma unroll
    for (int i = 0; i < 4; ++i) { const float4 s = p[i]; t += (s.x + s.y) + (s.z + s.w); }
    return rsqrtf(t * (1.f / D) + EPS); }

#define XB_TMO      128
#define XB_XCNT(j)  (256  + 64 * (j))
#define XB_XSUB(j)  (1280 + 64 * (j))
#define XB_XGEN(j)  (2304 + 64 * (j))
#define XB_TOP      3328
#define XB_TOPGEN   3392
#define XCD_BAR_WORDS 3456
#define XB_SPIN_CAP (1u << 18)
__device__ __forceinline__ unsigned xb_ld(unsigned* p)              { return __hip_atomic_load(p, __ATOMIC_RELAXED, __HIP_MEMORY_SCOPE_AGENT); }
__device__ __forceinline__ unsigned xb_add(unsigned* p, unsigned v) { return __hip_atomic_fetch_add(p, v, __ATOMIC_RELAXED, __HIP_MEMORY_SCOPE_AGENT); }
__device__ __forceinline__ unsigned xb_xcc_id() { return (unsigned)__builtin_amdgcn_s_getreg((3 << 11) | 20) & 0xFu; }
#define XB_SPIN(cond, bar) do { unsigned _sp = 0; while (cond) { __builtin_amdgcn_s_sleep(1); \
    if ((++_sp & 255u) == 0u) { if (xb_ld(&(bar)[XB_TMO])) break; if (_sp > XB_SPIN_CAP) { atomicAdd(&(bar)[XB_TMO], 1u); break; } } } } while (0)
struct XcdBarrier { unsigned* bar; unsigned x; volatile LAS unsigned* st; };
__device__ __forceinline__ XcdBarrier xcd_barrier_post(unsigned* bar, volatile LAS unsigned* st) {
    XcdBarrier b; b.bar = bar; b.x = xb_xcc_id(); b.st = st;
    if (threadIdx.x == 0) (void)xb_add(&bar[XB_XCNT(b.x)], 1u);
    return b;
}
__device__ __forceinline__ void xcd_barrier_complete(unsigned* bar, unsigned x, unsigned& nloc, unsigned& nx) {
    const unsigned G = gridDim.x * gridDim.y * gridDim.z;
    unsigned sum, cnt, mine, sp = 0u;
    for (;;) {
        sum = 0u; cnt = 0u; mine = 0u;
#pragma unroll
        for (unsigned j = 0; j < 16; ++j) { const unsigned c = xb_ld(&bar[XB_XCNT(j)]); sum += c; cnt += (c > 0u) ? 1u : 0u; mine = (j == x) ? c : mine; }
        if (sum == G) break;
        __builtin_amdgcn_s_sleep(1);
        if ((++sp & 255u) == 0u) { if (xb_ld(&bar[XB_TMO])) break; if (sp > XB_SPIN_CAP) { atomicAdd(&bar[XB_TMO], 1u); break; } }
    }
    nloc = mine > 0u ? mine : 1u; nx = cnt > 0u ? cnt : 1u;
}
__device__ __forceinline__ void xcd_barrier(const XcdBarrier& b) {
    asm volatile("s_waitcnt vmcnt(0)" ::: "memory");
    __syncthreads();
    if (threadIdx.x == 0) {
        unsigned* bar = b.bar;
        __builtin_amdgcn_s_waitcnt(0);
        unsigned nloc = b.st[0], nx = b.st[1];
        if (nloc == 0u) { xcd_barrier_complete(bar, b.x, nloc, nx); b.st[0] = nloc; b.st[1] = nx; }
        const unsigned old = xb_add(&bar[XB_XSUB(b.x)], 1u);
        const unsigned gen = old / nloc;
        if (old + 1u == (gen + 1u) * nloc) {
            __builtin_amdgcn_fence(__ATOMIC_RELEASE, "agent");
            asm volatile("s_waitcnt vmcnt(0)" ::: "memory");
            const unsigned og = xb_add(&bar[XB_TOP], 1u);
            const unsigned tg = og / nx;
            if (og + 1u == (tg + 1u) * nx) xb_add(&bar[XB_TOPGEN], 1u);
            else XB_SPIN(xb_ld(&bar[XB_TOPGEN]) == tg, bar);
            __builtin_amdgcn_fence(__ATOMIC_ACQUIRE, "agent");
            xb_add(&bar[XB_XGEN(b.x)], 1u);
            asm volatile("s_waitcnt vmcnt(0)" ::: "memory");
        } else {
            XB_SPIN(xb_ld(&bar[XB_XGEN(b.x)]) == gen, bar);
            __builtin_amdgcn_fence(__ATOMIC_ACQUIRE, "agent");
            asm volatile("s_waitcnt vmcnt(0)" ::: "memory");
        }
    }
    __syncthreads();
}

struct Args { const float* in[24]; float* out; unsigned char* ws; int ph_lo, ph_hi; };
struct Frame {
    const Args& A; LAS unsigned char* lds; int tid, lane, wave, gw, NGW, gt, NGT;
    __device__ __forceinline__ Frame(const Args& a) : A(a) {}
    __device__ __forceinline__ const float* x() const { return A.in[0]; }
    __device__ __forceinline__ const float* c() const { return A.in[1]; }
    __device__ __forceinline__ const float* ctx() const { return A.in[2]; }
    __device__ __forceinline__ const float* c_ctx() const { return A.in[3]; }
    __device__ __forceinline__ const float* w_mod() const { return A.in[4]; }
    __device__ __forceinline__ const float* b_mod() const { return A.in[5]; }
    __device__ __forceinline__ const float* ev_w_in() const { return A.in[6]; }
    __device__ __forceinline__ const float* ev_w_out() const { return A.in[7]; }
    __device__ __forceinline__ const float* lq1() const { return A.in[8]; }
    __device__ __forceinline__ const float* lk1() const { return A.in[9]; }
    __device__ __forceinline__ const float* lq2() const { return A.in[10]; }
    __device__ __forceinline__ const float* lk2() const { return A.in[11]; }
    __device__ __forceinline__ const float* subln() const { return A.in[12]; }
    __device__ __forceinline__ const float* pool_w() const { return A.in[13]; }
    __device__ __forceinline__ const float* pool_scale() const { return A.in[14]; }
    __device__ __forceinline__ const float* hg_w_in() const { return A.in[15]; }
    __device__ __forceinline__ const float* hg_w_out() const { return A.in[16]; }
    __device__ __forceinline__ const float* lb_logits() const { return A.in[17]; }
    __device__ __forceinline__ const float* hg_norm() const { return A.in[18]; }
    __device__ __forceinline__ const float* w_up() const { return A.in[19]; }
    __device__ __forceinline__ const float* conv_w() const { return A.in[20]; }
    __device__ __forceinline__ const float* conv_b() const { return A.in[21]; }
    __device__ __forceinline__ const float* w_down() const { return A.in[22]; }
    __device__ __forceinline__ const float* final_norm() const { return A.in[23]; }
    __device__ __forceinline__ float* out() const { return A.out; }
    __device__ __forceinline__ unsigned char* ws() const { return A.ws; }
    __device__ __forceinline__ float* mods() const { return (float*)(A.ws + OFF_MODS); }
    __device__ __forceinline__ float* rope() const { return (float*)(A.ws + OFF_ROPE); }
    __device__ __forceinline__ float* misc() const { return (float*)(A.ws + OFF_MISC); }
    __device__ __forceinline__ float* ssq() const { return (float*)(A.ws + OFF_SSQ); }
    __device__ __forceinline__ float* bup() const { return (float*)(A.ws + OFF_BUP); }
    __device__ __forceinline__ float* bin1() const { return (float*)(A.ws + OFF_BIN1); }
    __device__ __forceinline__ float* xc() const { return (float*)(A.ws + OFF_XC); }
    __device__ __forceinline__ bf16_t* Win0() const { return (bf16_t*)(A.ws + OFF_WIN0); }
    __device__ __forceinline__ bf16_t* Wout0() const { return (bf16_t*)(A.ws + OFF_WOUT0); }
    __device__ __forceinline__ bf16_t* Wup0() const { return (bf16_t*)(A.ws + OFF_WUP0); }
    __device__ __forceinline__ bf16_t* Wdn0() const { return (bf16_t*)(A.ws + OFF_WDN0); }
    __device__ __forceinline__ bf16_t* Win1() const { return (bf16_t*)(A.ws + OFF_WIN1); }
    __device__ __forceinline__ bf16_t* Wout1() const { return (bf16_t*)(A.ws + OFF_WOUT1); }
    __device__ __forceinline__ bf16_t* Wup1() const { return (bf16_t*)(A.ws + OFF_WUP1); }
    __device__ __forceinline__ bf16_t* Wdn1() const { return (bf16_t*)(A.ws + OFF_WDN1); }
    __device__ __forceinline__ bf16_t* A0() const { return (bf16_t*)(A.ws + OFF_A); }
    __device__ __forceinline__ bf16_t* A1() const { return (bf16_t*)(A.ws + OFF_A1); }
    __device__ __forceinline__ bf16_t* P0() const { return (bf16_t*)(A.ws + OFF_P0); }
    __device__ __forceinline__ bf16_t* ON() const { return (bf16_t*)(A.ws + OFF_ON); }
    __device__ __forceinline__ bf16_t* G() const { return (bf16_t*)(A.ws + OFF_G); }
    __device__ __forceinline__ bf16_t* UCH() const { return (bf16_t*)(A.ws + OFF_UCH); }
    __device__ __forceinline__ bf16_t* Q1() const { return (bf16_t*)(A.ws + OFF_Q1); }
    __device__ __forceinline__ bf16_t* GG1() const { return (bf16_t*)(A.ws + OFF_GG1); }
    __device__ __forceinline__ bf16_t* V1() const { return (bf16_t*)(A.ws + OFF_V1); }
    __device__ __forceinline__ bf16_t* OF() const { return (bf16_t*)(A.ws + OFF_OF); }
    __device__ __forceinline__ bf16_t* OB() const { return (bf16_t*)(A.ws + OFF_OB); }
    __device__ __forceinline__ bf16_t* A3() const { return (bf16_t*)(A.ws + OFF_A3); }
    __device__ __forceinline__ f16_t* LF1() const { return (f16_t*)(A.ws + OFF_LF1); }
    __device__ __forceinline__ f16_t* LB1() const { return (f16_t*)(A.ws + OFF_LB1); }
};

__device__ __forceinline__ void ph_mods(Frame& F) {
    LAS float* s = (LAS float*)F.lds;
    LAS float* red = (LAS float*)(F.lds + 36864);
    if ((int)blockIdx.x >= 192) return;
    for (int i = F.tid; i < 9 * 1024; i += NTHR) { const int r = i >> 10, k = i & 1023; s[i] = silu_f(r < 8 ? F.c()[r * 1024 + k] : F.c_ctx()[k]); }
    __syncthreads();
    const int kg = F.tid >> 6, cl = F.tid & 63;
    for (int item = blockIdx.x; item < 192; item += gridDim.x) {
        const int l = item / 96, col = (item % 96) * 64 + cl;
        float acc[9];
#pragma unroll
        for (int r = 0; r < 9; ++r) acc[r] = 0.f;
        const float* w = F.w_mod() + (size_t)l * 1024 * 6144 + col;
        for (int k0 = kg * 128; k0 < kg * 128 + 128; k0 += 16) { float wv[16];
#pragma unroll
            for (int q = 0; q < 16; ++q) wv[q] = w[(size_t)(k0 + q) * 6144];
#pragma unroll
            for (int q = 0; q < 16; ++q)
#pragma unroll
                for (int r = 0; r < 9; ++r) acc[r] += s[r * 1024 + k0 + q] * wv[q]; }
#pragma unroll
        for (int r = 0; r < 9; ++r) red[(kg * 9 + r) * 64 + cl] = acc[r];
        __syncthreads();
        if (kg == 0) {
#pragma unroll
            for (int r = 0; r < 9; ++r) { float t = 0.f;
#pragma unroll
                for (int g = 0; g < 8; ++g) t += red[(g * 9 + r) * 64 + cl];
                F.mods()[((size_t)l * 9 + r) * 6144 + col] = F.b_mod()[l * 6144 + col] + t; }
        }
        __syncthreads();
    }
}
__device__ __forceinline__ void ph_small(Frame& F) {
    if (blockIdx.x != gridDim.x - 1) return;
    const int tid = F.tid;
    if (tid == 0) { float s1 = 0.f, s2 = 0.f; for (int i = 0; i < 64; ++i) { s1 += F.lq1()[i] * F.lk1()[i]; s2 += F.lq2()[i] * F.lk2()[i]; } F.misc()[0] = expf(s1) - expf(s2) + 0.2f; }
    F.misc()[64 + tid] = F.subln()[tid] * 0.8f;
    for (int i = tid; i < 2048; i += NTHR) { const int dir = i >> 10, ch = i & 1023; const float l0 = F.lb_logits()[(dir * 2 + 0) * 1024 + ch], l1 = F.lb_logits()[(dir * 2 + 1) * 1024 + ch];
        const float m = fmaxf(l0, l1), e0 = expf(l0 - m), e1 = expf(l1 - m); F.misc()[1024 + i] = e1 / (e0 + e1); }
    for (int i = tid; i < 1024; i += NTHR) { const int pos = i >> 4, f = i & 15; const float inv = powf(10000.0f, -(float)f / 16.0f); const float ang = (float)pos * inv; F.rope()[i] = cosf(ang); F.rope()[1024 + i] = sinf(ang); }
}
__device__ __forceinline__ void transpose_item(const float* W, int K, int N, bf16_t* WT, int ldt, int mode, LAS float* scr, int item, int lane) {
    const int nblk = N / 32, kb = item / nblk, nb = item % nblk, k0 = 64 * kb, n0 = 32 * nb;
#pragma unroll 16
    for (int i = 0; i < 32; ++i) { const int kk = 2 * i + (lane >> 5); scr[kk * 33 + (lane & 31)] = W[(size_t)(k0 + kk) * N + n0 + (lane & 31)]; }
    asm volatile("s_waitcnt lgkmcnt(0)" ::: "memory");
    const int c = lane & 7;
#pragma unroll
    for (int j = 0; j < 4; ++j) { const int nn = (lane >> 3) + 8 * j; const LAS float* s = scr + (8 * c) * 33 + nn;
        uint4 o; o.x = pk2(s[0 * 33], s[1 * 33]); o.y = pk2(s[2 * 33], s[3 * 33]); o.z = pk2(s[4 * 33], s[5 * 33]); o.w = pk2(s[6 * 33], s[7 * 33]);
        const int n = n0 + nn; int np = n;
        if (mode == 1) { const int ch = n < FF ? n : n - FF; np = (ch >> 7) * 256 + (ch & 127) + (n < FF ? 0 : 128); }
        *(uint4*)(WT + (size_t)np * ldt + k0 + 8 * c) = o; }
    asm volatile("s_waitcnt lgkmcnt(0)" ::: "memory");
}
__device__ __forceinline__ void ph_transposes(Frame& F) {
    LAS float* scr = (LAS float*)(F.lds + 57344 + F.wave * 8448);
    constexpr int I0 = 16 * 64, I1 = 8 * 32, I2 = 16 * 176, I3 = 44 * 32, I4 = 16 * 160, I5 = 16 * 32;
    constexpr int NIT = I0 + I1 + I2 + I3 + I4 + I5;
    for (int it = F.gw; it < NIT; it += F.NGW) {
        int r = it;
        if (r < I0) { transpose_item(F.ev_w_in(), 1024, EVN, F.Win0(), 1024, 0, scr, r, F.lane); continue; } r -= I0;
        if (r < I1) { transpose_item(F.ev_w_out(), 512, 1024, F.Wout0(), 1024, 0, scr, r, F.lane); continue; } r -= I1;
        if (r < I2) { transpose_item(F.w_up(), 1024, FF2, F.Wup0(), 1024, 1, scr, r, F.lane); continue; } r -= I2;
        if (r < I3) { transpose_item(F.w_down(), FF, 1024, F.Wdn0(), FF, 0, scr, r, F.lane); continue; } r -= I3;
        if (r < I4) { transpose_item(F.hg_w_in(), 1024, HGN, F.Win1(), 1024, 0, scr, r, F.lane); continue; } r -= I4;
        transpose_item(F.hg_w_out(), 1024, 1024, F.Wout1(), 1024, 0, scr, r, F.lane);
    }
}
__device__ __forceinline__ void ph_transposes_l1ffn(Frame& F) {
    LAS float* scr = (LAS float*)(F.lds + 57344 + F.wave * 8448);
    constexpr int I6 = 16 * 176, I7 = 44 * 32;
    for (int it = F.gw; it < I6 + I7; it += F.NGW) {
        if (it < I6) transpose_item(F.w_up() + (size_t)1024 * FF2, 1024, FF2, F.Wup1(), 1024, 1, scr, it, F.lane);
        else transpose_item(F.w_down() + (size_t)FF * 1024, FF, 1024, F.Wdn1(), FF, 0, scr, it - I6, F.lane);
    }
}
__device__ __forceinline__ void ph_weff(Frame& F) {
    for (int idx = F.gt; idx < 512 * 1024; idx += F.NGT) { const int gc = idx >> 10, n = idx & 1023, g = gc >> 7;
        float acc = 0.f; const float* pw = F.pool_w() + (size_t)gc * 128; const float* ps = F.pool_scale() + g * 128; const float* wo = F.ev_w_out() + (size_t)(512 + g * 128) * 1024 + n;
        for (int d0 = 0; d0 < 128; d0 += 16) { float wv[16];
#pragma unroll
            for (int q = 0; q < 16; ++q) wv[q] = wo[(size_t)(d0 + q) * 1024];
#pragma unroll
            for (int q = 0; q < 16; ++q) acc += pw[d0 + q] * ps[d0 + q] * wv[q]; }
        F.Wout0()[(size_t)n * 1024 + 512 + gc] = f2bf(acc); }
}
__device__ __forceinline__ void bias_item(const float* mods_l, int chunk, const bf16_t* Wt, int N, float* bias, int n, int lane) {
    float acc[9];
#pragma unroll
    for (int r = 0; r < 9; ++r) acc[r] = 0.f;
#pragma unroll 8
    for (int k = lane; k < 1024; k += 64) { const float w = bf2f(Wt[(size_t)n * 1024 + k]);
#pragma unroll
        for (int r = 0; r < 9; ++r) acc[r] += mods_l[(size_t)r * 6144 + chunk * 1024 + k] * w; }
#pragma unroll
    for (int r = 0; r < 9; ++r) { const float s = wave_sum(acc[r]); if (lane == 0) bias[(size_t)r * N + n] = s; }
}
__device__ __forceinline__ void ph_bias(Frame& F) {
    for (int it = F.gw; it < FF2 + HGN; it += F.NGW) {
        if (it < FF2) bias_item(F.mods(), 3, F.Wup0(), FF2, F.bup(), it, F.lane);
        else bias_item(F.mods() + 9 * 6144, 0, F.Win1(), HGN, F.bin1(), it - FF2, F.lane);
    }
}
__device__ __forceinline__ void ph_bias_up1(Frame& F) {
    for (int it = F.gw; it < FF2; it += F.NGW) bias_item(F.mods() + 9 * 6144, 3, F.Wup1(), FF2, F.bup() + 9 * FF2, it, F.lane);
}
__device__ __forceinline__ void ph_norm_mod(Frame& F) {
    for (int row = F.gw; row < ROWS; row += F.NGW) {
        const float* xr = row < LAT ? F.x() + (size_t)row * D : F.ctx() + (size_t)(row - LAT) * D;
        const float* m = F.mods() + (size_t)mod_row(row) * 6144;
        float4 v[4]; float s = 0.f;
#pragma unroll
        for (int j = 0; j < 4; ++j) { v[j] = *(const float4*)(xr + j * 256 + F.lane * 4); s += (v[j].x * v[j].x + v[j].y * v[j].y) + (v[j].z * v[j].z + v[j].w * v[j].w); }
        const float rstd = rsqrtf(wave_sum(s) * (1.f / D) + EPS);
#pragma unroll
        for (int j = 0; j < 4; ++j) { const int c0 = j * 256 + F.lane * 4; const float4 sh = *(const float4*)(m + c0), sc = *(const float4*)(m + 1024 + c0);
            uint2 o; o.x = pk2(v[j].x * rstd * (1.f + sc.x) + sh.x, v[j].y * rstd * (1.f + sc.y) + sh.y); o.y = pk2(v[j].z * rstd * (1.f + sc.z) + sh.z, v[j].w * rstd * (1.f + sc.w) + sh.w);
            *(uint2*)(F.A0() + (size_t)row * D + c0) = o; }
    }
}
__device__ __forceinline__ void ph_rowssq(Frame& F, int nrows) {
    for (int row = F.gw; row < nrows; row += F.NGW) {
        const float* xr = row < LAT ? F.out() + (size_t)row * D : F.xc() + (size_t)(row - LAT) * D;
        float s = 0.f;
#pragma unroll
        for (int j = 0; j < 4; ++j) { const float4 v = *(const float4*)(xr + j * 256 + F.lane * 4); s += (v.x * v.x + v.y * v.y) + (v.z * v.z + v.w * v.w); }
        s = wave_sum(s);
        if (F.lane < 16) F.ssq()[(size_t)row * 16 + F.lane] = F.lane == 0 ? s : 0.f;
    }
}

template <class Epi>
__device__ __forceinline__ void gemm_naive_phase(Frame& F, const bf16_t* A, const bf16_t* Bt, int N, int K, int rowBeg, int rowEnd, const Epi& epi) {
    const int half = F.tid >> 8, tid = F.tid & 255, tx = tid & 15, ty = tid >> 4;
    LAS float* As = (LAS float*)(F.lds + half * 8320); LAS float* Bs = As + 16 * 65;
    const int tn = N / 64, tm = (rowEnd - rowBeg + 63) / 64, ntiles = tn * tm;
    const int lr = tid >> 2, lk = (tid & 3) * 4;
    for (int i = blockIdx.x; 2 * i < ntiles; i += gridDim.x) {
        const int tile = 2 * i + half, r0 = rowBeg + (tile / tn) * 64, c0 = (tile % tn) * 64;
        float acc[4][4];
#pragma unroll
        for (int a = 0; a < 4; ++a)
#pragma unroll
            for (int b = 0; b < 4; ++b) acc[a][b] = 0.f;
        int arow = r0 + lr; if (arow > rowEnd - 1) arow = rowEnd - 1;
        const bf16_t* ap = A + (long)arow * K + lk;
        const bf16_t* bp = Bt + (size_t)(c0 + lr) * K + lk;
        for (int k0 = 0; k0 < K; k0 += 16) {
            const ushort4 av = *(const ushort4*)(ap + k0), bv = *(const ushort4*)(bp + k0);
            As[(lk + 0) * 65 + lr] = bf2f(av.x); As[(lk + 1) * 65 + lr] = bf2f(av.y); As[(lk + 2) * 65 + lr] = bf2f(av.z); As[(lk + 3) * 65 + lr] = bf2f(av.w);
            Bs[(lk + 0) * 65 + lr] = bf2f(bv.x); Bs[(lk + 1) * 65 + lr] = bf2f(bv.y); Bs[(lk + 2) * 65 + lr] = bf2f(bv.z); Bs[(lk + 3) * 65 + lr] = bf2f(bv.w);
            __syncthreads();
#pragma unroll
            for (int k = 0; k < 16; ++k) { float a[4], b[4];
#pragma unroll
                for (int q = 0; q < 4; ++q) { a[q] = As[k * 65 + ty * 4 + q]; b[q] = Bs[k * 65 + tx * 4 + q]; }
#pragma unroll
                for (int q = 0; q < 4; ++q)
#pragma unroll
                    for (int j = 0; j < 4; ++j) acc[q][j] += a[q] * b[j]; }
            __syncthreads();
        }
#pragma unroll
        for (int q = 0; q < 4; ++q) { const int row = r0 + ty * 4 + q; if (row < rowEnd) {
#pragma unroll
            for (int j = 0; j < 4; ++j) epi(row, c0 + tx * 4 + j, acc[q][j]); } }
    }
}
struct EpiStore { bf16_t* C; long long ldc; __device__ void operator()(int row, int col, float v) const { C[(size_t)row * ldc + col] = f2bf(v); } };
struct EpiUp { bf16_t* U; long long rowBase; const float* ssq; const float* bias;
    __device__ void operator()(int row, int col, float v) const { if (row < 0 || row >= ROWS) return; U[(size_t)(row - rowBase) * FF2 + col] = f2bf(rstd_of(ssq, row) * v + bias[(size_t)mod_row(row) * FF2 + col]); } };
struct EpiResid { const float* xin_lat; const float* xin_ctx; float* xout_lat; float* xout_ctx; const float* gate; const float* scale_next; bf16_t* An;
    __device__ void operator()(int row, int col, float v) const {
        const int r = mod_row(row); const size_t o = row < LAT ? (size_t)row * D + col : (size_t)(row - LAT) * D + col;
        const float xo = (row < LAT ? xin_lat : xin_ctx)[o]; const float xn = xo + gate[(size_t)r * 6144 + col] * v;
        (row < LAT ? xout_lat : xout_ctx)[o] = xn;
        if (An) An[(size_t)row * D + col] = f2bf(xn * (1.f + scale_next[(size_t)r * 6144 + col])); } };
struct EpiIn1 { const float* ssq; const float* bias; const float* lbv; bf16_t* Q; bf16_t* GG; bf16_t* V; f16_t* LF; f16_t* LB;
    __device__ void operator()(int row, int col, float acc) const {
        const int blk = col >> 10, ch = col & 1023; const float val = rstd_of(ssq, row) * acc + bias[(size_t)mod_row(row) * HGN + col];
        if (blk == 0) { if (row < LAT) Q[(size_t)row * D + ch] = f2bf(silu_f(val)); }
        else if (blk == 1) V[(size_t)row * D + ch] = f2bf(val);
        else if (blk == 4) { if (row < LAT) GG[(size_t)row * D + ch] = f2bf(silu_f(val)); }
        else { const float lb = lbv[(blk - 2) * 1024 + ch]; const float f = lb + (1.f - lb) / (1.f + expf(-val)); (blk == 2 ? LF : LB)[(size_t)row * D + ch] = (f16_t)f; } } };


namespace pg8 {
#define PG8_LAS __attribute__((address_space(3)))
typedef unsigned short bf16_t;
typedef short bf16x8 __attribute__((ext_vector_type(8)));
typedef float f32x4 __attribute__((ext_vector_type(4)));
typedef unsigned u32x4 __attribute__((ext_vector_type(4)));
constexpr int BM = 256, BK = 64, HALF = 128, HTB = HALF * BK * 2  , STAGE_BYTES = 8 * HTB, NXCD = 8, WGM = 8;

__host__ __device__ __forceinline__ int lds_byte(int r, int c) { const int st = (r >> 4) * 2 + (c >> 5), rr = r & 15, cc = c & 31, ob = rr * 64 + cc * 2; return st * 1024 + (ob ^ (((ob >> 9) & 1) << 5)); }
__host__ __device__ __forceinline__ void stage_rc(int b, int& R, int& C) { const int st = b / 1024, sb = b % 1024, swz = sb ^ (((sb >> 9) & 1) << 5); R = (st >> 1) * 16 + swz / 64; C = (st & 1) * 32 + (swz % 64) / 2; }
__host__ __device__ __forceinline__ int perm32(int rho) { const int n = rho >> 4, i = rho & 15; return 8 * (i >> 2) + 4 * n + (i & 3); }

struct Unit { int pm, pn; };
struct Gemm { const bf16_t* A; const bf16_t* Bt; int M, N, K; int achunk; };

struct StaticOrder {
    int nM, nN, nwg, G, c;
    __host__ __device__ void init(int M, int N, int G_, int c_) { nM = M / BM; nN = N / BM; nwg = nM * nN; G = G_; c = c_; }
    __host__ __device__ void init2(int nM_, int nN_, int G_, int c_) { nM = nM_; nN = nN_; nwg = nM * nN; G = G_; c = c_; }
    __host__ __device__ bool next(int i, Unit& u) const {
        const long L = (long)i * G + c; if (L >= nwg) return false;
        int wgid = (int)L; { const int q = nwg / NXCD, r = nwg % NXCD, xcd = wgid % NXCD, off = wgid / NXCD; wgid = (xcd < r ? xcd * (q + 1) : r * (q + 1) + (xcd - r) * q) + off; }
        const int nig = WGM * nN, gid = wgid / nig, fm = gid * WGM, gsz = (nM - fm) < WGM ? (nM - fm) : WGM;
        u.pm = fm + ((wgid % nig) % gsz); u.pn = (wgid % nig) / gsz; return true;
    }
    __device__ __forceinline__ void a_ready(const Unit&) const {}
    __device__ __forceinline__ void done(const Unit&) const {}
};
template <class Epi, class Sched, bool ALIGN_EPI = false, bool SP2 = false>
__device__ __forceinline__ void gemm_phase(PG8_LAS unsigned char* lds, const Gemm g, const Sched& S, const Epi& E) {
    const int tid = threadIdx.x, wid = __builtin_amdgcn_readfirstlane(tid >> 6), lane = tid & 63, wr = wid >> 2, wc = wid & 3, fr = lane & 15, fq = lane >> 4;
    const int K = g.K, nt = K / BK;
    unsigned voffA[2], voffB[2];
#pragma unroll
    for (int i = 0; i < 2; ++i) { int R, C; stage_rc(tid * 16 + i * 8192, R, C); const int Rb = Epi::PERM ? ((R & ~31) + perm32(R & 31)) : R;
        const int Ra = g.achunk ? (62 * (R >> 6) + 4 * (R & 15) + ((R >> 4) & 3)) : R;
        voffA[i] = (unsigned)(Ra * K + C) * 2u; voffB[i] = (unsigned)(Rb * K + C) * 2u; }
    const size_t kstep = (size_t)(BK * 2);
    const size_t hstep = (size_t)HALF * K * 2;
    const size_t tstep = 2 * hstep;
    const size_t hstepA = g.achunk ? (size_t)124 * K * 2 : hstep, tstepA = 2 * hstepA;
    const unsigned ldsw = (unsigned)wid * 1024u;
    const int aoff = lds_byte(wr * 64 + fr, fq * 8), boff = lds_byte(wc * 32 + fr, fq * 8);
#define PG8_SA(b, h) (((b) * 2 + (h)) * HTB)
#define PG8_SB(b, h) ((4 + (b) * 2 + (h)) * HTB)
#define PG8_STAGE(bufoff, gbase, voff) do { _Pragma("unroll") for (int _i = 0; _i < 2; ++_i) \
        __builtin_amdgcn_global_load_lds((const unsigned*)((const char*)(gbase) + (voff)[_i]), (PG8_LAS unsigned*)(lds + (bufoff) + ldsw + _i * 8192), 16, 0, 0); } while (0)
#define PG8_LDA(dst, b, h) do { _Pragma("unroll") for (int m = 0; m < 4; ++m) _Pragma("unroll") for (int k = 0; k < 2; ++k) dst[m][k] = *(const PG8_LAS bf16x8*)(lds + PG8_SA(b, h) + aoff + m * 2048 + k * 1024); } while (0)
#define PG8_LDB(dst, b, h) do { _Pragma("unroll") for (int n = 0; n < 2; ++n) _Pragma("unroll") for (int k = 0; k < 2; ++k) dst[n][k] = *(const PG8_LAS bf16x8*)(lds + PG8_SB(b, h) + boff + n * 2048 + k * 1024); } while (0)
#define PG8_MMA(ai, bj, At, Bt) do { __builtin_amdgcn_s_setprio(1); _Pragma("unroll") for (int m = 0; m < 4; ++m) _Pragma("unroll") for (int n = 0; n < 2; ++n) _Pragma("unroll") for (int k = 0; k < 2; ++k) \
        acc[ai][bj][m][n] = __builtin_amdgcn_mfma_f32_16x16x32_bf16(Bt[n][k], At[m][k], acc[ai][bj][m][n], 0, 0, 0); __builtin_amdgcn_s_setprio(0); } while (0)
#define PG8_WAIT_V(n) asm volatile("s_waitcnt vmcnt(" #n ")" ::: "memory")
#define PG8_WAIT_L(n) asm volatile("s_waitcnt lgkmcnt(" #n ")" ::: "memory")
#define PG8_BAR __builtin_amdgcn_s_barrier()
#define PG8_SCHED __builtin_amdgcn_sched_barrier(0)
    Unit cur, nxt; int ui = 0;
    if (!S.next(0, cur)) return;
    f32x4 acc[2][2][4][2];
#pragma unroll
    for (int a = 0; a < 2; ++a)
#pragma unroll
        for (int b = 0; b < 2; ++b)
#pragma unroll
            for (int m = 0; m < 4; ++m)
#pragma unroll
                for (int n = 0; n < 2; ++n) acc[a][b][m][n] = (f32x4){0.f, 0.f, 0.f, 0.f};
    bf16x8 At[4][2], B0[2][2], B1[2][2];
    const char* cA = (const char*)g.A + (size_t)cur.pm * tstepA; const char* cB = (const char*)g.Bt + (size_t)cur.pn * tstep;
    S.a_ready(cur);
    if constexpr (SP2) {
        PG8_STAGE(PG8_SB(0, 0), cB, voffB); PG8_STAGE(PG8_SB(0, 1), cB + hstep, voffB); PG8_STAGE(PG8_SA(0, 0), cA, voffA); PG8_STAGE(PG8_SA(0, 1), cA + hstepA, voffA);
        if (wr == 1) PG8_BAR;
        PG8_WAIT_V(2); PG8_BAR;
        PG8_STAGE(PG8_SB(1, 0), cB + kstep, voffB); PG8_STAGE(PG8_SA(1, 0), cA + kstep, voffA); PG8_STAGE(PG8_SB(1, 1), cB + hstep + kstep, voffB);
        PG8_WAIT_V(6); PG8_BAR;
    } else {
        PG8_STAGE(PG8_SB(0, 0), cB, voffB); PG8_STAGE(PG8_SA(0, 0), cA, voffA); PG8_STAGE(PG8_SB(0, 1), cB + hstep, voffB); PG8_STAGE(PG8_SA(0, 1), cA + hstepA, voffA);
        if (wr == 1) PG8_BAR;
        PG8_WAIT_V(4); PG8_BAR;
        PG8_STAGE(PG8_SB(1, 0), cB + kstep, voffB); PG8_STAGE(PG8_SA(1, 0), cA + kstep, voffA); PG8_STAGE(PG8_SB(1, 1), cB + hstep + kstep, voffB);
        PG8_WAIT_V(6); PG8_BAR;
    }
    for (;;) {
        const bool has_next = S.next(ui + 1, nxt);
        const char* nA = has_next ? (const char*)g.A + (size_t)nxt.pm * tstepA : cA; const char* nB = has_next ? (const char*)g.Bt + (size_t)nxt.pn * tstep : cB;
        for (int t = 0; t < nt; t += 2) {
            const bool last = (t == nt - 2);
            const char* a1 = cA + (size_t)(t + 1) * kstep;
            const char* a2 = last ? nA : cA + (size_t)(t + 2) * kstep; const char* b2 = last ? nB : cB + (size_t)(t + 2) * kstep;
            const char* a3 = a2 + kstep; const char* b3 = b2 + kstep;
            if (last && has_next) S.a_ready(nxt);
            if constexpr (SP2) {
            PG8_LDB(B0, 0, 0); PG8_LDB(B1, 0, 1); PG8_SCHED; PG8_LDA(At, 0, 0); PG8_STAGE(PG8_SA(1, 1), a1 + hstepA, voffA);
            PG8_WAIT_V(8); PG8_WAIT_L(0); PG8_BAR; PG8_MMA(0, 0, At, B0); PG8_MMA(0, 1, At, B1); PG8_BAR; PG8_SCHED;
            PG8_LDA(At, 0, 1); PG8_STAGE(PG8_SB(0, 0), b2, voffB); PG8_STAGE(PG8_SB(0, 1), b2 + hstep, voffB); PG8_STAGE(PG8_SA(0, 0), a2, voffA);
            PG8_WAIT_V(8); PG8_WAIT_L(0); PG8_BAR; PG8_MMA(1, 0, At, B0); PG8_MMA(1, 1, At, B1); PG8_BAR; PG8_SCHED;
            PG8_LDB(B0, 1, 0); PG8_LDB(B1, 1, 1); PG8_SCHED; PG8_LDA(At, 1, 0); PG8_STAGE(PG8_SA(0, 1), a2 + hstepA, voffA);
            PG8_WAIT_V(8); PG8_WAIT_L(0); PG8_BAR; PG8_MMA(0, 0, At, B0); PG8_MMA(0, 1, At, B1); PG8_BAR; PG8_SCHED;
            PG8_LDA(At, 1, 1); PG8_STAGE(PG8_SB(1, 0), b3, voffB); PG8_STAGE(PG8_SB(1, 1), b3 + hstep, voffB); PG8_STAGE(PG8_SA(1, 0), a3, voffA);
            PG8_WAIT_V(8); PG8_WAIT_L(0); PG8_BAR; PG8_MMA(1, 0, At, B0); PG8_MMA(1, 1, At, B1); PG8_BAR; PG8_SCHED;
            } else {
            PG8_LDB(B0, 0, 0); PG8_SCHED; PG8_LDA(At, 0, 0); PG8_STAGE(PG8_SA(1, 1), a1 + hstepA, voffA);
            PG8_WAIT_L(8); PG8_BAR; PG8_WAIT_L(0); PG8_MMA(0, 0, At, B0); PG8_BAR; PG8_SCHED;
            PG8_LDB(B1, 0, 1); PG8_STAGE(PG8_SB(0, 0), b2, voffB);
            PG8_BAR; PG8_WAIT_L(0); PG8_MMA(0, 1, At, B1); PG8_BAR;
            PG8_LDA(At, 0, 1); PG8_STAGE(PG8_SA(0, 0), a2, voffA);
            PG8_BAR; PG8_WAIT_L(0); PG8_MMA(1, 0, At, B0); PG8_BAR; PG8_SCHED;
            PG8_STAGE(PG8_SB(0, 1), b2 + hstep, voffB);
            PG8_WAIT_V(6); PG8_BAR; PG8_MMA(1, 1, At, B1); PG8_BAR;
            PG8_LDB(B0, 1, 0); PG8_SCHED; PG8_LDA(At, 1, 0); PG8_STAGE(PG8_SA(0, 1), a2 + hstepA, voffA);
            PG8_WAIT_L(8); PG8_BAR; PG8_WAIT_L(0); PG8_MMA(0, 0, At, B0); PG8_BAR; PG8_SCHED;
            PG8_LDB(B1, 1, 1); PG8_STAGE(PG8_SB(1, 0), b3, voffB);
            PG8_BAR; PG8_WAIT_L(0); PG8_MMA(0, 1, At, B1); PG8_BAR;
            PG8_LDA(At, 1, 1); PG8_STAGE(PG8_SA(1, 0), a3, voffA);
            PG8_BAR; PG8_WAIT_L(0); PG8_MMA(1, 0, At, B0); PG8_BAR; PG8_SCHED;
            PG8_STAGE(PG8_SB(1, 1), b3 + hstep, voffB);
            PG8_WAIT_V(6); PG8_BAR; PG8_MMA(1, 1, At, B1); PG8_BAR;
            }
        }
        if constexpr (ALIGN_EPI) { if (wr == 0) PG8_BAR; }
        if constexpr (!Epi::AFTER_DRAIN) { E(acc, cur, wr, wc, fr, fq); S.done(cur); }
        if (!has_next) break;
#pragma unroll
        for (int a = 0; a < 2; ++a)
#pragma unroll
            for (int b = 0; b < 2; ++b)
#pragma unroll
                for (int m = 0; m < 4; ++m)
#pragma unroll
                    for (int n = 0; n < 2; ++n) acc[a][b][m][n] = (f32x4){0.f, 0.f, 0.f, 0.f};
        cur = nxt; cA = nA; cB = nB; ++ui;
        if constexpr (ALIGN_EPI) { if (wr == 1) PG8_BAR; }
    }
    PG8_WAIT_V(0);
    if constexpr (!ALIGN_EPI) { if (wr == 0) PG8_BAR; }
    PG8_BAR;
    if constexpr (Epi::AFTER_DRAIN) { E.fused(acc, cur, wr, wc, fr, fq, lds, wid, lane); S.done(cur); }
#undef PG8_SA
#undef PG8_SB
#undef PG8_STAGE
#undef PG8_LDA
#undef PG8_LDB
#undef PG8_MMA
#undef PG8_WAIT_V
#undef PG8_WAIT_L
#undef PG8_BAR
#undef PG8_SCHED
}
}

#define PG8_ALIGN true
#define PG8_SP2 true
namespace mk {
using pg8::f32x4; using pg8::u32x4; using pg8::Unit; using pg8::BM; using pg8::HALF;
typedef unsigned u32x2 __attribute__((ext_vector_type(2)));
__device__ __forceinline__ unsigned cvt_pk_bf16(float lo, float hi) { unsigned r; asm volatile("v_cvt_pk_bf16_f32 %0, %1, %2" : "=v"(r) : "v"(lo), "v"(hi)); return r; }
__device__ __forceinline__ float rstd16(const float* ssq, int row) { const f32x4* p = (const f32x4*)(ssq + (size_t)row * 16); const f32x4 a = p[0], b = p[1], c = p[2], d = p[3];
    return rsqrtf((((a[0] + a[1]) + (a[2] + a[3])) + ((b[0] + b[1]) + (b[2] + b[3])) + ((c[0] + c[1]) + (c[2] + c[3])) + ((d[0] + d[1]) + (d[2] + d[3]))) * (1.f / D) + EPS); }
struct EpiStoreMK { static constexpr bool PERM = true, AFTER_DRAIN = false; bf16_t* O; long long ldc;
    __device__ __forceinline__ void operator()(const f32x4 (&acc)[2][2][4][2], const Unit& u, int wr, int wc, int fr, int fq) const {
        const int row0 = u.pm * BM + wr * 64 + fr, col0 = u.pn * BM + wc * 32 + 8 * fq;
#pragma unroll
        for (int ai = 0; ai < 2; ++ai)
#pragma unroll
            for (int m = 0; m < 4; ++m) { bf16_t* rowp = O + (size_t)(row0 + ai * HALF + m * 16) * ldc + col0;
#pragma unroll
                for (int bj = 0; bj < 2; ++bj) { const f32x4 v0 = acc[ai][bj][m][0], v1 = acc[ai][bj][m][1];
                    u32x4 w; w.x = cvt_pk_bf16(v0[0], v0[1]); w.y = cvt_pk_bf16(v0[2], v0[3]); w.z = cvt_pk_bf16(v1[0], v1[1]); w.w = cvt_pk_bf16(v1[2], v1[3]);
                    *(u32x4*)(rowp + bj * HALF) = w; } }
    } };
struct EpiIn0MK { static constexpr bool PERM = false, AFTER_DRAIN = false; bf16_t* O; const float* rope;
    __device__ __forceinline__ void operator()(const f32x4 (&acc)[2][2][4][2], const Unit& u, int wr, int wc, int fr, int fq) const {
        const int rowt = u.pm * BM; const bool lat = rowt < LAT; const bool qk = u.pn < 4; const float sc = u.pn < 2 ? QSCALE : 1.f; const int axis = wc & 1;
#pragma unroll
        for (int ai = 0; ai < 2; ++ai)
#pragma unroll
            for (int m = 0; m < 4; ++m) { const int row = rowt + ai * HALF + wr * 64 + m * 16 + fr; bf16_t* rowp = O + (size_t)row * EVN + u.pn * BM + wc * 32 + 4 * fq;
                f32x4 c = {1.f, 1.f, 1.f, 1.f}, sn = {0.f, 0.f, 0.f, 0.f};
                if (qk && lat) { const int t = row & 2047, pos = axis == 0 ? (t >> 6) : (t & 63); c = *(const f32x4*)(rope + pos * 16 + 4 * fq); sn = *(const f32x4*)(rope + 1024 + pos * 16 + 4 * fq); }
#pragma unroll
                for (int bj = 0; bj < 2; ++bj) { const f32x4 x1 = acc[ai][bj][m][0], x2 = acc[ai][bj][m][1];
                    const f32x4 o1 = (x1 * c - x2 * sn) * sc, o2 = (x2 * c + x1 * sn) * sc;
                    u32x2 w1, w2; w1.x = cvt_pk_bf16(o1[0], o1[1]); w1.y = cvt_pk_bf16(o1[2], o1[3]); w2.x = cvt_pk_bf16(o2[0], o2[1]); w2.y = cvt_pk_bf16(o2[2], o2[3]);
                    *(u32x2*)(rowp + bj * HALF) = w1; *(u32x2*)(rowp + bj * HALF + 16) = w2; } }
    } };
struct EpiResidMK { static constexpr bool PERM = false, AFTER_DRAIN = false;
    const float* xin_lat; const float* xin_ctx; float* xout_lat; float* xout_ctx; const float* gate; const float* scale_next; bf16_t* An; float* ssq;
    __device__ __forceinline__ void operator()(const f32x4 (&acc)[2][2][4][2], const Unit& u, int wr, int wc, int fr, int fq) const {
        const int rowt = u.pm * BM; const bool lat = rowt < LAT; const int r = lat ? (rowt >> 11) : 8;
        const float* xin = lat ? xin_lat + (size_t)rowt * D : xin_ctx + (size_t)(rowt - LAT) * D; float* xout = lat ? xout_lat + (size_t)rowt * D : xout_ctx + (size_t)(rowt - LAT) * D;
        const int colb = u.pn * BM + wc * 32 + 4 * fq;
        float q[2][4];
#pragma unroll
        for (int ai = 0; ai < 2; ++ai)
#pragma unroll
            for (int m = 0; m < 4; ++m) q[ai][m] = 0.f;
#pragma unroll
        for (int bj = 0; bj < 2; ++bj)
#pragma unroll
            for (int n = 0; n < 2; ++n) { const int col = colb + bj * HALF + n * 16;
                const f32x4 gv = *(const f32x4*)(gate + (size_t)r * 6144 + col);
                const f32x4 sv = scale_next ? *(const f32x4*)(scale_next + (size_t)r * 6144 + col) + 1.0f : (f32x4){1.f, 1.f, 1.f, 1.f};
#pragma unroll
                for (int ai = 0; ai < 2; ++ai)
#pragma unroll
                    for (int m = 0; m < 4; ++m) { const size_t off = (size_t)(ai * HALF + wr * 64 + m * 16 + fr) * D + col;
                        const f32x4 xn = *(const f32x4*)(xin + off) + gv * acc[ai][bj][m][n];
                        *(f32x4*)(xout + off) = xn; q[ai][m] += (xn[0] * xn[0] + xn[1] * xn[1]) + (xn[2] * xn[2] + xn[3] * xn[3]);
                        if (An) { const f32x4 a = xn * sv; u32x2 w; w.x = cvt_pk_bf16(a[0], a[1]); w.y = cvt_pk_bf16(a[2], a[3]); *(u32x2*)(An + (size_t)rowt * D + off) = w; } }
                asm volatile("" ::: "memory"); }
        if (ssq) {
#pragma unroll
            for (int ai = 0; ai < 2; ++ai)
#pragma unroll
                for (int m = 0; m < 4; ++m) { float t = q[ai][m]; t += __shfl_xor(t, 16); t += __shfl_xor(t, 32);
                    if (fq == 0) ssq[(size_t)(rowt + ai * HALF + wr * 64 + m * 16 + fr) * 16 + u.pn * 4 + wc] = t; } }
    } };
__device__ __forceinline__ float fast_sigmoid(float x) { return __builtin_amdgcn_rcpf(1.f + __builtin_amdgcn_exp2f(-1.4426950408889634f * x)); }
struct EpiIn1MK { static constexpr bool PERM = true, AFTER_DRAIN = false;
    const float* ssq; const float* bias; const float* lbv; bf16_t* Q; bf16_t* GG; bf16_t* V; f16_t* LF; f16_t* LB;
    template <int KIND>
    __device__ __forceinline__ void body(const f32x4 (&acc)[2][2][4][2], unsigned short* dst, const float* lbp, int rowt, int r, int colb, int chb, int wr, int fr) const {
#pragma unroll
        for (int bj = 0; bj < 2; ++bj) {
            f32x4 bv[2], lbw[2];
#pragma unroll
            for (int n = 0; n < 2; ++n) { bv[n] = *(const f32x4*)(bias + (size_t)r * HGN + colb + bj * HALF + 4 * n);
                lbw[n] = KIND == 2 ? *(const f32x4*)(lbp + chb + bj * HALF + 4 * n) : (f32x4){0.f, 0.f, 0.f, 0.f}; }
#pragma unroll
            for (int ai = 0; ai < 2; ++ai)
#pragma unroll
                for (int m = 0; m < 4; ++m) { const int row = rowt + ai * HALF + wr * 64 + m * 16 + fr; float v[8]; const float rsv = rstd16(ssq, row);
#pragma unroll
                    for (int n = 0; n < 2; ++n)
#pragma unroll
                        for (int e = 0; e < 4; ++e) { float val = rsv * acc[ai][bj][m][n][e] + bv[n][e];
                            if (KIND == 0) val = val * fast_sigmoid(val);
                            else if (KIND == 2) { const float lb = lbw[n][e]; val = lb + (1.f - lb) * fast_sigmoid(val); }
                            v[n * 4 + e] = val; }
                    u32x4 w;
                    if (KIND == 2) { typedef _Float16 h2 __attribute__((ext_vector_type(2)));
                        h2 a = {(_Float16)v[0], (_Float16)v[1]}, b = {(_Float16)v[2], (_Float16)v[3]}, c = {(_Float16)v[4], (_Float16)v[5]}, d = {(_Float16)v[6], (_Float16)v[7]};
                        w.x = __builtin_bit_cast(unsigned, a); w.y = __builtin_bit_cast(unsigned, b); w.z = __builtin_bit_cast(unsigned, c); w.w = __builtin_bit_cast(unsigned, d); }
                    else { w.x = cvt_pk_bf16(v[0], v[1]); w.y = cvt_pk_bf16(v[2], v[3]); w.z = cvt_pk_bf16(v[4], v[5]); w.w = cvt_pk_bf16(v[6], v[7]); }
                    *(u32x4*)(dst + (size_t)row * D + chb + bj * HALF) = w; }
            asm volatile("" ::: "memory"); }
    }
    __device__ __forceinline__ void operator()(const f32x4 (&acc)[2][2][4][2], const Unit& u, int wr, int wc, int fr, int fq) const {
        const int rowt = u.pm * BM; const int r = rowt < LAT ? (rowt >> 11) : 8; const int blk = u.pn >> 2;
        const int colb = u.pn * BM + wc * 32 + 8 * fq, chb = (u.pn & 3) * BM + wc * 32 + 8 * fq;
        if (blk == 0) body<0>(acc, Q, lbv, rowt, r, colb, chb, wr, fr);
        else if (blk == 4) body<0>(acc, GG, lbv, rowt, r, colb, chb, wr, fr);
        else if (blk == 1) body<1>(acc, V, lbv, rowt, r, colb, chb, wr, fr);
        else if (blk == 2) body<2>(acc, (unsigned short*)LF, lbv, rowt, r, colb, chb, wr, fr);
        else body<2>(acc, (unsigned short*)LB, lbv + 1024, rowt, r, colb, chb, wr, fr);
    } };
struct EpiUpConvMK { static constexpr bool PERM = false, AFTER_DRAIN = false;
    const float* ssq; const float* bias; const float* cw; const float* cb; bf16_t* G; long long nrows;
    __device__ __forceinline__ static f32x4 dpp4(const f32x4 v, bool shr) { f32x4 r;
#pragma unroll
        for (int e = 0; e < 4; ++e) r[e] = shr ? __int_as_float(__builtin_amdgcn_update_dpp(0, __float_as_int(v[e]), 0x111, 0xf, 0xf, true)) : __int_as_float(__builtin_amdgcn_update_dpp(0, __float_as_int(v[e]), 0x101, 0xf, 0xf, true));
        return r; }
    __device__ __forceinline__ void conv_block(f32x4 (&o)[4], const f32x4 (&acc)[2][2][4][2], int ai, int bj, int n, const float* wp, const float* bp0, const float (&rs)[4], const int (&rr)[4], const bool (&first)[4], const bool (&last)[4], int colv) const {
        f32x4 uu[4];
#pragma unroll
        for (int m = 0; m < 4; ++m) uu[m] = rs[m] * acc[ai][bj][m][n] + *(const f32x4*)(bias + (size_t)rr[m] * FF2 + colv + bj * HALF);
        const f32x4 w0 = *(const f32x4*)(wp), w1 = *(const f32x4*)(wp + FF2), w2 = *(const f32x4*)(wp + 2 * FF2), bb = *(const f32x4*)(bp0);
        const f32x4 pp = dpp4(uu[3], true), nn = dpp4(uu[0], false); const f32x4 z = {0.f, 0.f, 0.f, 0.f};
#pragma unroll
        for (int m = 0; m < 4; ++m) { const f32x4 vp = first[m] ? z : (m == 0 ? pp : uu[m == 0 ? 0 : m - 1]), vn = last[m] ? z : (m == 3 ? nn : uu[m == 3 ? 3 : m + 1]);
            o[m] = vp * w0 + (uu[m] * w1 + (vn * w2 + bb)); }
    }
    __device__ __forceinline__ void operator()(const f32x4 (&acc)[2][2][4][2], const Unit& u, int wr, int wc, int fr, int fq) const {
        const int nr = (int)nrows;
#pragma unroll
        for (int ai = 0; ai < 2; ++ai) {
            const int tok0 = 62 * (4 * u.pm + 2 * ai + wr) - 1 + 4 * fr;
            float rs[4]; int rr[4]; bool first[4], last[4];
#pragma unroll
            for (int m = 0; m < 4; ++m) { const int tok = tok0 + m; int tc = tok < 0 ? 0 : tok; tc = tc > ROWS - 1 ? ROWS - 1 : tc; rs[m] = rstd16(ssq, tc); rr[m] = mod_row(tc);
                const int sp = tok < LAT ? (tok & 2047) : (tok & 255); first[m] = sp == 0; last[m] = sp == (tok < LAT ? 2047 : 255); }
#pragma unroll
            for (int n = 0; n < 2; ++n) {
                const int ch0 = u.pn * 128 + wc * 32 + n * 16 + 4 * fq, colv = u.pn * BM + wc * 32 + n * 16 + 4 * fq;
                f32x4 sg[4], av[4];
                conv_block(sg, acc, ai, 1, n, cw + FF + ch0, cb + FF + ch0, rs, rr, first, last, colv);
#pragma unroll
                for (int m = 0; m < 4; ++m)
#pragma unroll
                    for (int e = 0; e < 4; ++e) sg[m][e] = sg[m][e] * fast_sigmoid(sg[m][e]);
                asm volatile("" : "+v"(sg[0]), "+v"(sg[1]), "+v"(sg[2]), "+v"(sg[3]));
                conv_block(av, acc, ai, 0, n, cw + ch0, cb + ch0, rs, rr, first, last, colv);
#pragma unroll
                for (int m = 0; m < 4; ++m) { const int tok = tok0 + m, i = 4 * fr + m; const f32x4 o = av[m] * sg[m];
                    if (i >= 1 && i <= 62 && tok < nr) { u32x2 w; w.x = cvt_pk_bf16(o[0], o[1]); w.y = cvt_pk_bf16(o[2], o[3]); *(u32x2*)(G + (size_t)tok * FF + ch0) = w; } }
                asm volatile("" ::: "memory");
            }
        }
    } };
struct OrderIn1 { pg8::StaticOrder lat; int G, c;
    __device__ void init(int G_, int c_) { lat.init(LAT, HGN, G_, c_); G = G_; c = c_; }
    __device__ bool next(int i, Unit& u) const { if (lat.next(i, u)) return true; const long L = (long)i * G + c - lat.nwg; if (L < 0 || L >= 96) return false; u.pm = 64 + (int)(L / 12); u.pn = 4 + (int)(L % 12); return true; }
    __device__ __forceinline__ void a_ready(const Unit&) const {}
    __device__ __forceinline__ void done(const Unit&) const {} };
}

__device__ __forceinline__ void ph_rope(Frame& F) {
    for (int idx = F.gt; idx < ROWS * 512; idx += F.NGT) { const int row = idx >> 9, pi = idx & 511;
        const int col = (pi >> 4) * 32 + (pi & 15); const int axis = (col >> 5) & 1, f = col & 15;
        bf16_t* p = F.P0() + (size_t)row * EVN + col;
        float x1 = bf2f(p[0]), x2 = bf2f(p[16]);
        if (row < LAT) { const int t = row & 2047; const int pos = axis == 0 ? (t >> 6) : (t & 63); const float c = F.rope()[pos * 16 + f], s = F.rope()[1024 + pos * 16 + f];
            const float o1 = x1 * c - x2 * s, o2 = x2 * c + x1 * s; x1 = o1; x2 = o2; }
        if (col < 512) { x1 *= QSCALE; x2 *= QSCALE; }
        p[0] = f2bf(x1); p[16] = f2bf(x2); }
}
__device__ __forceinline__ void ph_attn_naive(Frame& F) {
    const bf16_t* P = F.P0();
    for (int it = F.gw; it < (ROWS / 64) * 8; it += F.NGW) {
        const int qb = __builtin_amdgcn_readfirstlane(it >> 3), hm = __builtin_amdgcn_readfirstlane(it & 7), h = hm >> 1, m = hm & 1; const int row = qb * 64 + F.lane;
        const bool lat = (qb * 64) < LAT; const int b = lat ? (qb * 64) >> 11 : (qb * 64 - LAT) >> 8;
        float q[64]; { const bf16_t* qp = P + (size_t)row * EVN + h * 128 + m * 64;
#pragma unroll
            for (int d = 0; d < 64; ++d) q[d] = bf2f(qp[d]); }
        float o[128];
#pragma unroll
        for (int d = 0; d < 128; ++d) o[d] = 0.f;
        float mx = -1e30f, l = 0.f; const int nkeys = lat ? 2304 : 256;
        for (int j = 0; j < nkeys; ++j) {
            const int krow = j < 256 ? LAT + b * 256 + j : b * 2048 + (j - 256);
            const bf16_t* kp = P + (size_t)krow * EVN + 512 + h * 128 + m * 64; const bf16_t* vp = P + (size_t)krow * EVN + 1024 + h * 128;
            float s = 0.f;
#pragma unroll
            for (int d = 0; d < 64; ++d) s += q[d] * bf2f(kp[d]);
            const float mn = fmaxf(mx, s), alpha = exp2f(mx - mn), p = exp2f(s - mn); l = l * alpha + p; mx = mn;
#pragma unroll
            for (int d = 0; d < 128; ++d) o[d] = o[d] * alpha + p * bf2f(vp[d]);
        }
        const float il = 1.f / l; bf16_t* op = F.ON() + (((size_t)row * 4 + h) * 2 + m) * 128;
#pragma unroll
        for (int d = 0; d < 128; ++d) op[d] = f2bf(o[d] * il);
    }
}
__device__ __forceinline__ void ph_readout0(Frame& F) {
    const float lam = F.misc()[0];
    for (int w = F.gw; w < ROWS * 4; w += F.NGW) { const int row = w >> 2, h = w & 3, lane = F.lane;
        const bf16_t* p = F.ON() + ((size_t)row * 4 + h) * 256;
        const float a = bf2f(p[lane]) - lam * bf2f(p[128 + lane]), b = bf2f(p[64 + lane]) - lam * bf2f(p[192 + lane]);
        const float rstd = rsqrtf(wave_sum(a * a + b * b) * (1.f / 128.f) + EPS);
        F.A1()[(size_t)row * D + h * 128 + lane] = f2bf(a * rstd * F.misc()[64 + h * 128 + lane]);
        F.A1()[(size_t)row * D + h * 128 + 64 + lane] = f2bf(b * rstd * F.misc()[64 + h * 128 + 64 + lane]); }
}
template <int W> __device__ __forceinline__ void pool_item(const bf16_t* P, bf16_t* A1, int row, int c0) {
    const int T = row < LAT ? 2048 : 256, t = row < LAT ? (row & 2047) : ((row - LAT) & 255), base = row - t;
    int lo = t - W / 2; if (lo < 0) lo = 0; int hi = t + W - W / 2; if (hi > T) hi = T;
    uint4 v[W];
#pragma unroll
    for (int j = 0; j < W; ++j) { int tt = t - W / 2 + j; tt = tt < 0 ? 0 : (tt > T - 1 ? T - 1 : tt); v[j] = *(const uint4*)(P + (size_t)(base + tt) * EVN + 1536 + c0); }
    float sum[8], self[8];
#pragma unroll
    for (int e = 0; e < 8; ++e) { sum[e] = 0.f; self[e] = 0.f; }
#pragma unroll
    for (int j = 0; j < W; ++j) { const int tt = t - W / 2 + j; const bool in = tt >= lo && tt < hi; const unsigned* u = (const unsigned*)&v[j];
#pragma unroll
        for (int e = 0; e < 4; ++e) { const float a = __uint_as_float(u[e] << 16), b = __uint_as_float(u[e] & 0xffff0000u);
            if (in) { sum[2 * e] += a; sum[2 * e + 1] += b; }
            if (j == W / 2) { self[2 * e] = a; self[2 * e + 1] = b; } } }
    const float inv = 1.f / (float)(hi - lo);
    uint4 o; o.x = pk2(sum[0] * inv - self[0], sum[1] * inv - self[1]); o.y = pk2(sum[2] * inv - self[2], sum[3] * inv - self[3]);
    o.z = pk2(sum[4] * inv - self[4], sum[5] * inv - self[5]); o.w = pk2(sum[6] * inv - self[6], sum[7] * inv - self[7]);
    *(uint4*)(A1 + (size_t)row * D + 512 + c0) = o;
}
__device__ __forceinline__ void ph_pool_d(Frame& F) {
    const bf16_t* P = F.P0(); bf16_t* A1 = F.A1();
    for (int it = F.gw; it < (ROWS / 4) * 4; it += F.NGW) {
        const int g = it & 3, row = (it >> 2) * 4 + (F.lane >> 4), c0 = g * 128 + (F.lane & 15) * 8;
        if (g == 0) pool_item<2>(P, A1, row, c0); else if (g == 1) pool_item<4>(P, A1, row, c0); else if (g == 2) pool_item<8>(P, A1, row, c0); else pool_item<16>(P, A1, row, c0);
    }
}
namespace att {
using bf16x8 = __attribute__((ext_vector_type(8))) short;
using s16x4  = __attribute__((ext_vector_type(4))) short;
using f32x16 = __attribute__((ext_vector_type(16))) float;
using u32x4  = __attribute__((ext_vector_type(4))) unsigned;
constexpr int QBLK = 32, KVBLK = 64, LDP = EVN;
constexpr int SHM_V = 16384, SHM_K = 8192, L_V = 0, L_K = 2 * SHM_V, L_WS = L_K + 2 * SHM_K, L_ST = L_WS + 2048, L_END = L_ST + 8 * 8192;
constexpr float THR2 = 8.f;
#define KSWZ64(row, colB) ((row) * 128 + ((colB) ^ (((row) & 7) << 4)))
#define ASBAR() __builtin_amdgcn_sched_barrier(0)
__device__ __forceinline__ int crow(int r, int hi) { return (r & 3) + 8 * (r >> 2) + 4 * hi; }
__device__ __forceinline__ unsigned cvtpk(float lo, float hi) { unsigned r; asm volatile("v_cvt_pk_bf16_f32 %0, %1, %2" : "=v"(r) : "v"(lo), "v"(hi)); return r; }
__device__ __forceinline__ void partialSM(f32x16& p0, f32x16& p1, float& m_reg, float& mn, float& alpha) {
  float pmax = p0[0];
#pragma unroll
  for (int r = 1; r < 16; ++r) pmax = fmaxf(pmax, p0[r]);
#pragma unroll
  for (int r = 0; r < 16; ++r) pmax = fmaxf(pmax, p1[r]);
  { auto rr = __builtin_amdgcn_permlane32_swap(__float_as_uint(pmax), __float_as_uint(pmax), false, false); pmax = fmaxf(__uint_as_float(rr[0]), __uint_as_float(rr[1])); }
  if (__builtin_expect(__all(pmax - m_reg <= THR2), 1)) { mn = m_reg; alpha = 1.f; }
  else { mn = fmaxf(m_reg, pmax); alpha = __builtin_amdgcn_exp2f(m_reg - mn); m_reg = mn; }
#pragma unroll
  for (int r = 0; r < 16; ++r) p0[r] -= mn;
#pragma unroll
  for (int r = 0; r < 16; ++r) p1[r] -= mn;
#pragma unroll
  for (int r = 0; r < 16; ++r) p0[r] = __builtin_amdgcn_exp2f(p0[r]);
}
__device__ __forceinline__ void finishSM(f32x16& p0, f32x16& p1, float alpha, float& l_reg, bf16x8& pa0, bf16x8& pa1, bf16x8& pa2, bf16x8& pa3) {
#pragma unroll
  for (int r = 0; r < 16; ++r) p1[r] = __builtin_amdgcn_exp2f(p1[r]);
  float ps = 0;
#pragma unroll
  for (int r = 0; r < 16; ++r) ps += p0[r];
#pragma unroll
  for (int r = 0; r < 16; ++r) ps += p1[r];
  { auto rr = __builtin_amdgcn_permlane32_swap(__float_as_uint(ps), __float_as_uint(ps), false, false); ps = __uint_as_float(rr[0]) + __uint_as_float(rr[1]); }
  l_reg = l_reg * alpha + ps;
#define PK4(P, BASE, OUT) do { unsigned a0 = cvtpk(P[BASE + 0], P[BASE + 1]), a1 = cvtpk(P[BASE + 2], P[BASE + 3]);   \
    unsigned b0 = cvtpk(P[BASE + 4], P[BASE + 5]), b1 = cvtpk(P[BASE + 6], P[BASE + 7]);                              \
    auto r0 = __builtin_amdgcn_permlane32_swap(a0, b0, false, false); auto r1 = __builtin_amdgcn_permlane32_swap(a1, b1, false, false); \
    u32x4 w = {r0[0], r1[0], r0[1], r1[1]}; OUT = *reinterpret_cast<bf16x8*>(&w); } while (0)
  PK4(p0, 0, pa0); PK4(p0, 8, pa1); PK4(p1, 0, pa2); PK4(p1, 8, pa3);
#undef PK4
}
__device__ __forceinline__ void qkt(f32x16& p0, f32x16& p1, const char* Ks, const bf16x8* qr, int r32, int hi) {
  p0 = f32x16{}; p1 = f32x16{};
#pragma unroll
  for (int d0 = 0; d0 < 4; ++d0) { const int cb = (d0 * 16 + hi * 8) * 2;
    const bf16x8 b0 = *reinterpret_cast<const bf16x8*>(Ks + KSWZ64(r32, cb));
    const bf16x8 b1 = *reinterpret_cast<const bf16x8*>(Ks + KSWZ64(32 + r32, cb));
    p0 = __builtin_amdgcn_mfma_f32_32x32x16_bf16(b0, qr[d0], p0, 0, 0, 0);
    p1 = __builtin_amdgcn_mfma_f32_32x32x16_bf16(b1, qr[d0], p1, 0, 0, 0); }
}
__device__ __forceinline__ int v_st(int k, int c) { const int kk = (k & ~0xC) | ((k & 4) << 1) | ((k & 8) >> 1); return ((kk >> 3) * 4 + (c >> 5)) * 512 + ((kk & 7) * 32 + (c & 31)) * 2; }
__device__ __forceinline__ int v_rd_base(int lane) { return ((lane & 3) << 3) | (((lane >> 2) & 3) << 6) | (((lane >> 4) & 1) << 5) | (((lane >> 5) & 1) << 8); }
constexpr int v_rd_off(int d0, int ks, int half) { return d0 * 512 + ks * 4096 + half * 2048; }
template <int OFF> __device__ __forceinline__ s16x4 tr_read(int vb) { s16x4 r; asm volatile("ds_read_b64_tr_b16 %0, %1 offset:%2" : "=&v"(r) : "v"(vb), "i"(OFF) : "memory"); return r; }
template <int D0> __device__ __forceinline__ void pv_one(f32x16& od, int vb, bf16x8 pa0, bf16x8 pa1, bf16x8 pa2, bf16x8 pa3) {
  const s16x4 l0 = tr_read<v_rd_off(D0, 0, 0)>(vb), h0 = tr_read<v_rd_off(D0, 0, 1)>(vb), l1 = tr_read<v_rd_off(D0, 1, 0)>(vb), h1 = tr_read<v_rd_off(D0, 1, 1)>(vb);
  const s16x4 l2 = tr_read<v_rd_off(D0, 2, 0)>(vb), h2 = tr_read<v_rd_off(D0, 2, 1)>(vb), l3 = tr_read<v_rd_off(D0, 3, 0)>(vb), h3 = tr_read<v_rd_off(D0, 3, 1)>(vb);
  asm volatile("s_waitcnt lgkmcnt(0)" ::: "memory"); ASBAR();
#define PK(L, H) (bf16x8){L[0], L[1], L[2], L[3], H[0], H[1], H[2], H[3]}
  od = __builtin_amdgcn_mfma_f32_32x32x16_bf16(pa0, PK(l0, h0), od, 0, 0, 0);
  od = __builtin_amdgcn_mfma_f32_32x32x16_bf16(pa1, PK(l1, h1), od, 0, 0, 0);
  od = __builtin_amdgcn_mfma_f32_32x32x16_bf16(pa2, PK(l2, h2), od, 0, 0, 0);
  od = __builtin_amdgcn_mfma_f32_32x32x16_bf16(pa3, PK(l3, h3), od, 0, 0, 0);
#undef PK
}
__device__ __forceinline__ void pv_d0(f32x16* o, int vb, bf16x8 pa0, bf16x8 pa1, bf16x8 pa2, bf16x8 pa3) {
  pv_one<0>(o[0], vb, pa0, pa1, pa2, pa3); pv_one<1>(o[1], vb, pa0, pa1, pa2, pa3); pv_one<2>(o[2], vb, pa0, pa1, pa2, pa3); pv_one<3>(o[3], vb, pa0, pa1, pa2, pa3);
}
struct KeyRows { int ctx0, lat0; bool isctx; __device__ __forceinline__ int operator()(int t) const { return (isctx || t < 4) ? ctx0 + 64 * t : lat0 + 64 * (t - 4); } };
__device__ __forceinline__ void attn_map(const bf16_t* __restrict__ Pq, const bf16_t* __restrict__ Pk, const bf16_t* __restrict__ Pv, const KeyRows kr, int NT, char* lds, f32x16 (&o)[4], float& l_out) {
  int tid_ = threadIdx.x; asm volatile("" : "+v"(tid_));
  const int tid = tid_, wid = tid >> 6, lane = tid & 63, r32 = lane & 31, hi = lane >> 5;
  char* V_lds = lds + L_V; char* K_lds = lds + L_K;
  float* wsf = (float*)(lds + L_WS) + wid * 64; float* al_l = wsf + 32;
  float m_reg = -1e30f, l_reg = 0; bf16x8 qr[4];
#pragma unroll
  for (int d = 0; d < 4; ++d) o[d] = f32x16{};
  const bf16_t* Qw = Pq + (long)(wid * QBLK + r32) * LDP + hi * 8;
#pragma unroll
  for (int d0 = 0; d0 < 4; ++d0) qr[d0] = *reinterpret_cast<const bf16x8*>(Qw + d0 * 16);
  const int sr = tid >> 4, sc = (tid & 15) * 8, vst0 = v_st(sr, sc), vst1 = v_st(32 + sr, sc);
  const int kr_ = tid >> 3, kc = (tid & 7) * 8, kst = KSWZ64(kr_, kc * 2);
  const int vb0 = (int)(uintptr_t)V_lds + v_rd_base(lane);
  struct { bf16x8 vs0, vs1, ks0; } sr_[1];
#define SLOAD(i, t) do { const long k0_ = kr(t); sr_[i].vs0 = *reinterpret_cast<const bf16x8*>(&Pv[(k0_ + sr) * LDP + sc]); sr_[i].vs1 = *reinterpret_cast<const bf16x8*>(&Pv[(k0_ + 32 + sr) * LDP + sc]); \
    sr_[i].ks0 = *reinterpret_cast<const bf16x8*>(&Pk[(k0_ + kr_) * LDP + kc]); } while (0)
#define SWRITE(b, i) do { *(bf16x8*)(V_lds + (b) * SHM_V + vst0) = sr_[i].vs0; *(bf16x8*)(V_lds + (b) * SHM_V + vst1) = sr_[i].vs1; *(bf16x8*)(K_lds + (b) * SHM_K + kst) = sr_[i].ks0; } while (0)
#define SWAIT() asm volatile("s_waitcnt vmcnt(0)" ::: "memory")
#define RESC(a) do { if (__any((a) < 1.f)) { if (hi == 0) al_l[r32] = (a); asm volatile("s_waitcnt lgkmcnt(0)" ::: "memory"); \
    _Pragma("unroll") for (int d = 0; d < 4; ++d) _Pragma("unroll") for (int r = 0; r < 16; ++r) o[d][r] *= al_l[crow(r, hi)]; } } while (0)
  f32x16 pA0, pA1, pB0, pB1; float mnA, mnB, alA, alB; bf16x8 pa0, pa1, pa2, pa3;
  constexpr int SE = 0, SO = 0;
  SLOAD(SE, 0); asm volatile("s_waitcnt vmcnt(0)" ::: "memory"); SWRITE(0, SE); __syncthreads();
  qkt(pA0, pA1, K_lds, qr, r32, hi); partialSM(pA0, pA1, m_reg, mnA, alA);
  SLOAD(SO, 1);
  SWAIT(); SWRITE(1, SO); __syncthreads();
  for (int j = 1; j + 1 < NT; j += 2) {
    ASBAR(); qkt(pB0, pB1, K_lds + SHM_K, qr, r32, hi);
    finishSM(pA0, pA1, alA, l_reg, pa0, pa1, pa2, pa3); ASBAR();
    SLOAD(SO, j + 1); ASBAR();
    pv_d0(o, vb0, pa0, pa1, pa2, pa3); partialSM(pB0, pB1, m_reg, mnB, alB);
    __syncthreads(); SWAIT(); SWRITE(0, SE);
    RESC(alB); __syncthreads();
    ASBAR(); qkt(pA0, pA1, K_lds, qr, r32, hi);
    finishSM(pB0, pB1, alB, l_reg, pa0, pa1, pa2, pa3); ASBAR();
    SLOAD(SE, j + 2); ASBAR();
    pv_d0(o, vb0 + SHM_V, pa0, pa1, pa2, pa3); partialSM(pA0, pA1, m_reg, mnA, alA);
    __syncthreads(); SWAIT(); SWRITE(1, SO);
    RESC(alA); __syncthreads();
  }
  ASBAR(); qkt(pB0, pB1, K_lds + SHM_K, qr, r32, hi);
  finishSM(pA0, pA1, alA, l_reg, pa0, pa1, pa2, pa3); ASBAR();
  pv_d0(o, vb0, pa0, pa1, pa2, pa3); partialSM(pB0, pB1, m_reg, mnB, alB);
  __syncthreads(); RESC(alB);
  finishSM(pB0, pB1, alB, l_reg, pa0, pa1, pa2, pa3); ASBAR();
  pv_d0(o, vb0 + SHM_V, pa0, pa1, pa2, pa3);
  l_out = l_reg;
#undef SLOAD
#undef SWRITE
#undef SWAIT
#undef RESC
}
__device__ __forceinline__ void attn_unit(const bf16_t* P0, int qrow0, int h, int ctx0, int lat0, bool isctx, float lam, const float* gain, bf16_t* A1, char* lds) {
  int tid_ = threadIdx.x; asm volatile("" : "+v"(tid_));
  const int tid = tid_, wid = tid >> 6, lane = tid & 63, r32 = lane & 31, hi = lane >> 5;
  float* wsf = (float*)(lds + L_WS) + wid * 64;
  bf16_t* stash = (bf16_t*)(lds + L_ST + wid * 8192);
  const KeyRows kr{ctx0, lat0, isctx}; const int NT = isctx ? 4 : 36;
  f32x16 o[4]; float l_reg;
  attn_map(P0 + (long)qrow0 * LDP + h * 128, P0 + 512 + h * 128, P0 + 1024 + h * 128, kr, NT, lds, o, l_reg);
  if (hi == 0) wsf[r32] = l_reg; asm volatile("s_waitcnt lgkmcnt(0)" ::: "memory");
#pragma unroll
  for (int r = 0; r < 16; ++r) { const float rl = __builtin_amdgcn_rcpf(wsf[crow(r, hi)]);
#pragma unroll
    for (int d0 = 0; d0 < 4; ++d0) stash[crow(r, hi) * 128 + d0 * 32 + r32] = f2bf(o[d0][r] * rl); }
  asm volatile("s_waitcnt lgkmcnt(0)" ::: "memory");
  __syncthreads();
  attn_map(P0 + (long)qrow0 * LDP + h * 128 + 64, P0 + 512 + h * 128 + 64, P0 + 1024 + h * 128, kr, NT, lds, o, l_reg);
  if (hi == 0) wsf[r32] = l_reg; asm volatile("s_waitcnt lgkmcnt(0)" ::: "memory");
  float ss[16];
#pragma unroll
  for (int r = 0; r < 16; ++r) { const float rl = lam * __builtin_amdgcn_rcpf(wsf[crow(r, hi)]); float t = 0.f;
#pragma unroll
    for (int d0 = 0; d0 < 4; ++d0) { const float v = bf2f(stash[crow(r, hi) * 128 + d0 * 32 + r32]) - o[d0][r] * rl; o[d0][r] = v; t += v * v; }
#pragma unroll
    for (int off = 1; off < 32; off <<= 1) t += __shfl_xor(t, off);
    ss[r] = rsqrtf(t * (1.f / 128.f) + EPS); }
#pragma unroll
  for (int d0 = 0; d0 < 4; ++d0) { const float g = gain[h * 128 + d0 * 32 + r32];
#pragma unroll
    for (int r = 0; r < 16; ++r) stash[crow(r, hi) * 128 + d0 * 32 + r32] = f2bf(o[d0][r] * ss[r] * g); }
  asm volatile("s_waitcnt lgkmcnt(0)" ::: "memory");
  bf16_t* Ow = A1 + (long)(qrow0 + wid * QBLK) * D + h * 128;
#pragma unroll
  for (int i = 0; i < 8; ++i) { const int row = i * 4 + (lane >> 4), ch = lane & 15; const u32x4 v = *(const u32x4*)(stash + row * 128 + ch * 8); *(u32x4*)(Ow + (long)row * D + ch * 8) = v; }
  asm volatile("s_waitcnt lgkmcnt(0)" ::: "memory");
  __syncthreads();
}
#undef KSWZ64
#undef ASBAR
}
__device__ __forceinline__ void ph_attn_mk(Frame& F) {
    const float lam = F.misc()[0]; const float* gain = F.misc() + 64;
    for (int u = blockIdx.x; u < 288; u += gridDim.x) {
        if (u < 256) { const int bh = u & 31, qb = u >> 5, b = bh >> 2, h = bh & 3; att::attn_unit(F.P0(), b * 2048 + qb * 256, h, LAT + b * 256, b * 2048, false, lam, gain, F.A1(), (char*)F.lds); }
        else { const int bh = u - 256, b = bh >> 2, h = bh & 3; att::attn_unit(F.P0(), LAT + b * 256, h, LAT + b * 256, 0, true, lam, gain, F.A1(), (char*)F.lds); }
    }
}
__device__ __forceinline__ void ph_convgate(Frame& F, int l, int rowBase, int rowBeg, int rowEnd) {
    const float* cw = F.conv_w() + (size_t)l * 3 * FF2; const float* cb = F.conv_b() + (size_t)l * FF2;
    const long n = (long)(rowEnd - rowBeg) * FF;
    for (long idx = F.gt; idx < n; idx += F.NGT) { const int row = rowBeg + (int)(idx / FF), ch = (int)(idx % FF);
        const int T = row < LAT ? 2048 : 256, t = row < LAT ? (row & 2047) : ((row - LAT) & 255);
        const int na = (ch >> 7) * 256 + (ch & 127), ng = na + 128;
        const bf16_t* u = F.UCH() + (size_t)(row - rowBase) * FF2;
        float a = bf2f(u[na]) * cw[FF2 + ch] + cb[ch], gt = bf2f(u[ng]) * cw[FF2 + FF + ch] + cb[FF + ch];
        if (t > 0) { a += bf2f(u[na - FF2]) * cw[ch]; gt += bf2f(u[ng - FF2]) * cw[FF + ch]; }
        if (t < T - 1) { a += bf2f(u[na + FF2]) * cw[2 * FF2 + ch]; gt += bf2f(u[ng + FF2]) * cw[2 * FF2 + FF + ch]; }
        F.G()[(size_t)row * FF + ch] = f2bf(a * silu_f(gt)); }
}
__device__ __forceinline__ void ph_scan_naive(Frame& F, int dir) {
    if ((int)blockIdx.x * 4 >= 64) return;
    const int vb = blockIdx.x * 4 + (F.tid >> 7), d = F.tid & 127;
    LAS float* qs = (LAS float*)(F.lds + (F.tid >> 7) * 1536); LAS float* fs = qs + 128; LAS float* ks = qs + 256;
    const int b = vb >> 3, h = vb & 7;
    float S[128];
#pragma unroll
    for (int c = 0; c < 128; ++c) S[c] = 0.f;
    const f16_t* L = dir ? F.LB1() : F.LF1();
    for (int step = 0; step < 2304; ++step) {
        const bool isctx = step < 256; const int t = isctx ? (dir ? 255 - step : step) : (dir ? 2047 - (step - 256) : (step - 256));
        const int row = isctx ? LAT + b * 256 + t : b * 2048 + t; const size_t o = (size_t)row * D + h * 128;
        const float f = (float)L[o + d]; fs[d] = f; ks[d] = 1.f - f; qs[d] = isctx ? 0.f : bf2f(F.Q1()[o + d]);
        const float v = bf2f(F.V1()[o + d]);
        __syncthreads();
        float acc = 0.f;
#pragma unroll
        for (int c = 0; c < 128; ++c) { S[c] = fs[c] * S[c] + ks[c] * v; acc += qs[c] * S[c]; }
        if (!isctx) (dir ? F.OB() : F.OF())[o + d] = f2bf(acc);
        __syncthreads();
    }
}
namespace scn {
using bf16x8 = __attribute__((ext_vector_type(8))) short;
using f32x16 = __attribute__((ext_vector_type(16))) float;
constexpr int L_Q = 0, L_K = 16384, L_KT = 32768, L_VT = 49152, L_ST = 57344, L_AM = 73728, L_X = 81920, L_VEC = L_X + 36864, L_END = L_VEC + 2048;
constexpr int X_T = 0, X_PX = 16384, X_PT = 32768, X_TOT = 34816;
__device__ __forceinline__ int sw256(int row, int byte) { return row * 256 + (((byte) & ~15) ^ ((row & 7) << 4)) + (byte & 15); }
__device__ __forceinline__ int sw128(int row, int byte) { return row * 128 + (((byte) & ~15) ^ ((row & 7) << 4)) + (byte & 15); }
__device__ __forceinline__ int crow(int r, int hi) { return (r & 3) + 8 * (r >> 2) + 4 * hi; }
__device__ __forceinline__ unsigned pkbf(float lo, float hi) { unsigned r; asm volatile("v_cvt_pk_bf16_f32 %0, %1, %2" : "=v"(r) : "v"(lo), "v"(hi)); return r; }
__device__ __forceinline__ void scan_unit(const bf16_t* __restrict__ Q1, const bf16_t* __restrict__ V1, const f16_t* __restrict__ Fg, bf16_t* __restrict__ Od, int b, int h, int dir, int half, char* lds) {
  int tid_ = threadIdx.x; asm volatile("" : "+v"(tid_));
  const int tid = tid_, lane = tid & 63, r32 = lane & 31, hi = lane >> 5; const int wid = __builtin_amdgcn_readfirstlane(tid >> 6);
  const int seg = tid >> 4, cg = tid & 15, tv = tid >> 3, dch = tid & 7, t0 = 2 * seg, t1 = t0 + 1;
  float* XF = (float*)(lds + L_X); float* VEC = (float*)(lds + L_VEC);
  const int colh = h * 128;
  for (int i = tid; i < 8192 / 16; i += 512) *(uint4*)(lds + L_AM + i * 16) = make_uint4(0u, 0u, 0u, 0u);
  f32x16 S0 = f32x16{}, S1 = f32x16{};
  uint4 rf0, rf1, rq0, rq1, rv;
#define CBASE(st) ((st) < 4 ? LAT + b * 256 + 64 * (dir ? 3 - (st) : (st)) : b * 2048 + 64 * (dir ? 35 - (st) : (st) - 4))
#define GROW(cb_, t) ((long)(cb_) + (dir ? 63 - (t) : (t)))
#define PREFETCH(st) do { const int cb_ = CBASE(st); rf0 = *(const uint4*)(Fg + GROW(cb_, t0) * D + colh + 8 * cg); rf1 = *(const uint4*)(Fg + GROW(cb_, t1) * D + colh + 8 * cg); \
    if ((st) >= 4) { rq0 = *(const uint4*)(Q1 + GROW(cb_, t0) * D + colh + 8 * cg); rq1 = *(const uint4*)(Q1 + GROW(cb_, t1) * D + colh + 8 * cg); } \
    rv = *(const uint4*)(V1 + GROW(cb_, tv) * D + colh + half * 64 + 8 * dch); } while (0)
  PREFETCH(0);
#pragma unroll 1
  for (int step = 0; step < 36; ++step) {
    const bool isctx = step < 4; const int cbase = CBASE(step);
    float fa[8], fb[8], p2[8];
    { typedef _Float16 h8 __attribute__((ext_vector_type(8))); const h8 a = __builtin_bit_cast(h8, rf0), c = __builtin_bit_cast(h8, rf1);
#pragma unroll
      for (int j = 0; j < 8; ++j) { fa[j] = (float)a[j]; fb[j] = (float)c[j]; p2[j] = fa[j] * fb[j]; } }
    __syncthreads();
    *(float4*)(XF + X_T / 4 + seg * 128 + 8 * cg) = make_float4(p2[0], p2[1], p2[2], p2[3]); *(float4*)(XF + X_T / 4 + seg * 128 + 8 * cg + 4) = make_float4(p2[4], p2[5], p2[6], p2[7]);
    __syncthreads();
    { const int c = tid & 127, part = tid >> 7; float pt = 1.f;
#pragma unroll
      for (int q = 0; q < 8; ++q) pt *= XF[X_T / 4 + (8 * part + q) * 128 + c];
      XF[X_PT / 4 + part * 128 + c] = pt; }
    __syncthreads();
    { const int c = tid & 127, part = tid >> 7; float base = 1.f;
#pragma unroll
      for (int q = 0; q < 3; ++q) if (q < part) base *= XF[X_PT / 4 + q * 128 + c];
#pragma unroll
      for (int q = 0; q < 8; ++q) { XF[X_PX / 4 + (8 * part + q) * 128 + c] = base; base *= XF[X_T / 4 + (8 * part + q) * 128 + c]; }
      if (part == 3) XF[X_TOT / 4 + c] = base; }
    __syncthreads();
    { float px[8], p31[8], ip31[8];
      { const float4 a = *(const float4*)(XF + X_PX / 4 + seg * 128 + 8 * cg), c = *(const float4*)(XF + X_PX / 4 + seg * 128 + 8 * cg + 4);
        px[0] = a.x; px[1] = a.y; px[2] = a.z; px[3] = a.w; px[4] = c.x; px[5] = c.y; px[6] = c.z; px[7] = c.w;
        const float4 e = *(const float4*)(XF + X_PX / 4 + 16 * 128 + 8 * cg), g = *(const float4*)(XF + X_PX / 4 + 16 * 128 + 8 * cg + 4);
        p31[0] = e.x; p31[1] = e.y; p31[2] = e.z; p31[3] = e.w; p31[4] = g.x; p31[5] = g.y; p31[6] = g.z; p31[7] = g.w; }
      float q0[8], q1[8];
      if (!isctx) { const unsigned* a = (const unsigned*)&rq0; const unsigned* c = (const unsigned*)&rq1;
#pragma unroll
        for (int j = 0; j < 4; ++j) { q0[2 * j] = __uint_as_float(a[j] << 16); q0[2 * j + 1] = __uint_as_float(a[j] & 0xffff0000u); q1[2 * j] = __uint_as_float(c[j] << 16); q1[2 * j + 1] = __uint_as_float(c[j] & 0xffff0000u); } }
      else {
#pragma unroll
        for (int j = 0; j < 8; ++j) { q0[j] = 0.f; q1[j] = 0.f; } }
      float qa[8], qb[8], ka[8], kb[8];
#pragma unroll
      for (int j = 0; j < 8; ++j) { p31[j] = fmaxf(p31[j], 1e-30f); ip31[j] = __builtin_amdgcn_rcpf(p31[j]);
        const float Pa = px[j] * fa[j], Pb = px[j] * p2[j];
        qa[j] = q0[j] * (Pa * ip31[j]); qb[j] = q1[j] * (Pb * ip31[j]);
        ka[j] = (1.f - fa[j]) * (p31[j] * __builtin_amdgcn_rcpf(fmaxf(Pa, 1e-30f))); kb[j] = (1.f - fb[j]) * (p31[j] * __builtin_amdgcn_rcpf(fmaxf(Pb, 1e-30f))); }
      *(uint4*)(lds + L_Q + sw256(t0, 16 * cg)) = make_uint4(pkbf(qa[0], qa[1]), pkbf(qa[2], qa[3]), pkbf(qa[4], qa[5]), pkbf(qa[6], qa[7]));
      *(uint4*)(lds + L_Q + sw256(t1, 16 * cg)) = make_uint4(pkbf(qb[0], qb[1]), pkbf(qb[2], qb[3]), pkbf(qb[4], qb[5]), pkbf(qb[6], qb[7]));
      *(uint4*)(lds + L_K + sw256(t0, 16 * cg)) = make_uint4(pkbf(ka[0], ka[1]), pkbf(ka[2], ka[3]), pkbf(ka[4], ka[5]), pkbf(ka[6], ka[7]));
      *(uint4*)(lds + L_K + sw256(t1, 16 * cg)) = make_uint4(pkbf(kb[0], kb[1]), pkbf(kb[2], kb[3]), pkbf(kb[4], kb[5]), pkbf(kb[6], kb[7]));
#pragma unroll
      for (int j = 0; j < 8; ++j) *(unsigned*)(lds + L_KT + sw128(8 * cg + j, 4 * seg)) = pkbf(ka[j], kb[j]);
      { const unsigned short* vv = (const unsigned short*)&rv;
#pragma unroll
        for (int j = 0; j < 8; ++j) *(unsigned short*)(lds + L_VT + sw128(8 * dch + j, 2 * tv)) = vv[j]; }
      if (seg == 0) {
#pragma unroll
        for (int j = 0; j < 8; ++j) { const float tot = XF[X_TOT / 4 + 8 * cg + j]; VEC[8 * cg + j] = tot; VEC[128 + 8 * cg + j] = tot * ip31[j]; } }
    }
    if (wid >= 4) { const int cb = wid - 4;
#pragma unroll
      for (int r4 = 0; r4 < 4; ++r4) { const int c0 = 32 * cb + 8 * r4 + 4 * hi; const float4 pv = *(const float4*)(XF + X_PX / 4 + 16 * 128 + c0);
        const float g0 = fmaxf(pv.x, 1e-30f), g1 = fmaxf(pv.y, 1e-30f), g2 = fmaxf(pv.z, 1e-30f), g3 = fmaxf(pv.w, 1e-30f);
        *(uint2*)(lds + L_ST + sw256(r32, 2 * c0)) = make_uint2(pkbf(S0[4 * r4] * g0, S0[4 * r4 + 1] * g1), pkbf(S0[4 * r4 + 2] * g2, S0[4 * r4 + 3] * g3));
        *(uint2*)(lds + L_ST + sw256(32 + r32, 2 * c0)) = make_uint2(pkbf(S1[4 * r4] * g0, S1[4 * r4 + 1] * g1), pkbf(S1[4 * r4 + 2] * g2, S1[4 * r4 + 3] * g3)); } }
    if (step + 1 < 36) PREFETCH(step + 1);
    __syncthreads();
    if (!isctx && wid < 3) { const int sb = wid == 2 ? 1 : 0, tb = wid == 0 ? 0 : 1; f32x16 acc = f32x16{};
#pragma unroll
      for (int ks = 0; ks < 8; ++ks) { const bf16x8 a = *(const bf16x8*)(lds + L_K + sw256(32 * sb + r32, (16 * ks + 8 * hi) * 2)), bq = *(const bf16x8*)(lds + L_Q + sw256(32 * tb + r32, (16 * ks + 8 * hi) * 2));
        acc = __builtin_amdgcn_mfma_f32_32x32x16_bf16(a, bq, acc, 0, 0, 0); }
      const int t = 32 * tb + r32;
#pragma unroll
      for (int r4 = 0; r4 < 4; ++r4) { const int s0 = 32 * sb + 8 * r4 + 4 * hi;
        const float x0 = (s0 + 0 <= t) ? acc[4 * r4 + 0] : 0.f, x1 = (s0 + 1 <= t) ? acc[4 * r4 + 1] : 0.f, x2 = (s0 + 2 <= t) ? acc[4 * r4 + 2] : 0.f, x3 = (s0 + 3 <= t) ? acc[4 * r4 + 3] : 0.f;
        *(uint2*)(lds + L_AM + sw128(t, 2 * s0)) = make_uint2(pkbf(x0, x1), pkbf(x2, x3)); } }
    if (wid >= 4) { const int cb = wid - 4; f32x16 U0 = f32x16{}, U1 = f32x16{};
#pragma unroll
      for (int ks = 0; ks < 4; ++ks) { const bf16x8 a = *(const bf16x8*)(lds + L_KT + sw128(32 * cb + r32, (16 * ks + 8 * hi) * 2));
        const bf16x8 v0 = *(const bf16x8*)(lds + L_VT + sw128(r32, (16 * ks + 8 * hi) * 2)), v1 = *(const bf16x8*)(lds + L_VT + sw128(32 + r32, (16 * ks + 8 * hi) * 2));
        U0 = __builtin_amdgcn_mfma_f32_32x32x16_bf16(a, v0, U0, 0, 0, 0); U1 = __builtin_amdgcn_mfma_f32_32x32x16_bf16(a, v1, U1, 0, 0, 0); }
#pragma unroll
      for (int r = 0; r < 16; ++r) { const int c = 32 * cb + crow(r, hi); const float dec = VEC[c], bco = VEC[128 + c]; S0[r] = dec * S0[r] + bco * U0[r]; S1[r] = dec * S1[r] + bco * U1[r]; } }
    __syncthreads();
    if (!isctx) { const int blk = wid & 3, tb = blk >> 1, db = blk & 1, kp = wid >> 2; f32x16 acc = f32x16{};
      if (kp == 0) {
#pragma unroll
        for (int ks = 0; ks < 4; ++ks) { const bf16x8 a = *(const bf16x8*)(lds + L_AM + sw128(32 * tb + r32, (16 * ks + 8 * hi) * 2)), v = *(const bf16x8*)(lds + L_VT + sw128(32 * db + r32, (16 * ks + 8 * hi) * 2));
          acc = __builtin_amdgcn_mfma_f32_32x32x16_bf16(a, v, acc, 0, 0, 0); }
#pragma unroll
        for (int ks = 0; ks < 2; ++ks) { const bf16x8 a = *(const bf16x8*)(lds + L_Q + sw256(32 * tb + r32, (16 * ks + 8 * hi) * 2)), v = *(const bf16x8*)(lds + L_ST + sw256(32 * db + r32, (16 * ks + 8 * hi) * 2));
          acc = __builtin_amdgcn_mfma_f32_32x32x16_bf16(a, v, acc, 0, 0, 0); }
      } else {
#pragma unroll
        for (int ks = 2; ks < 8; ++ks) { const bf16x8 a = *(const bf16x8*)(lds + L_Q + sw256(32 * tb + r32, (16 * ks + 8 * hi) * 2)), v = *(const bf16x8*)(lds + L_ST + sw256(32 * db + r32, (16 * ks + 8 * hi) * 2));
          acc = __builtin_amdgcn_mfma_f32_32x32x16_bf16(a, v, acc, 0, 0, 0); }
      }
#pragma unroll
      for (int r = 0; r < 16; ++r) XF[(kp * 64 + 32 * tb + crow(r, hi)) * 64 + 32 * db + r32] = acc[r]; }
    __syncthreads();
    if (!isctx) { const float4 a0 = *(const float4*)(XF + tv * 64 + 8 * dch), a1 = *(const float4*)(XF + tv * 64 + 8 * dch + 4), c0 = *(const float4*)(XF + (64 + tv) * 64 + 8 * dch), c1 = *(const float4*)(XF + (64 + tv) * 64 + 8 * dch + 4);
      *(uint4*)(Od + GROW(cbase, tv) * D + colh + half * 64 + 8 * dch) = make_uint4(pkbf(a0.x + c0.x, a0.y + c0.y), pkbf(a0.z + c0.z, a0.w + c0.w), pkbf(a1.x + c1.x, a1.y + c1.y), pkbf(a1.z + c1.z, a1.w + c1.w)); }
  }
  __syncthreads();
#undef CBASE
#undef GROW
#undef PREFETCH
}
}
__device__ __forceinline__ void ph_scan_mk(Frame& F) {
    for (int u = blockIdx.x; u < 256; u += gridDim.x) {
        const int x = u & 7, y = u >> 3, half = y & 1, g = (y >> 1) * 8 + x, dir = g & 1, bh = g >> 1, b = bh >> 3, h = bh & 7;
        scn::scan_unit(F.Q1(), F.V1(), dir ? F.LB1() : F.LF1(), dir ? F.OB() : F.OF(), b, h, dir, half, (char*)F.lds);
    }
}
__device__ __forceinline__ void ph_combine1(Frame& F) {
    const bf16_t* OFp = F.OF(); const bf16_t* OBp = F.OB(); const bf16_t* GG = F.GG1(); const float* hn = F.hg_norm(); bf16_t* A3 = F.A3();
    for (int it = F.gw; it < LAT * 8 / 4; it += F.NGW) {
        const int rh = it * 4 + (F.lane >> 4), row = rh >> 3, h = rh & 7; const size_t o = (size_t)row * D + h * 128 + (F.lane & 15) * 8;
        const uint4 a = *(const uint4*)(OFp + o), b = *(const uint4*)(OBp + o), g = *(const uint4*)(GG + o);
        const float4 n0 = *(const float4*)(hn + h * 128 + (F.lane & 15) * 8), n1 = *(const float4*)(hn + h * 128 + (F.lane & 15) * 8 + 4);
        const unsigned* au = (const unsigned*)&a; const unsigned* bu = (const unsigned*)&b; const unsigned* gu = (const unsigned*)&g;
        float v[8], gg[8]; float ss = 0.f;
#pragma unroll
        for (int e = 0; e < 4; ++e) { v[2 * e] = __uint_as_float(au[e] << 16) + __uint_as_float(bu[e] << 16); v[2 * e + 1] = __uint_as_float(au[e] & 0xffff0000u) + __uint_as_float(bu[e] & 0xffff0000u);
            gg[2 * e] = __uint_as_float(gu[e] << 16); gg[2 * e + 1] = __uint_as_float(gu[e] & 0xffff0000u); ss += v[2 * e] * v[2 * e] + v[2 * e + 1] * v[2 * e + 1]; }
        ss += __shfl_xor(ss, 1); ss += __shfl_xor(ss, 2); ss += __shfl_xor(ss, 4); ss += __shfl_xor(ss, 8);
        const float rstd = rsqrtf(ss * (1.f / 128.f) + EPS);
        const float nn[8] = {n0.x, n0.y, n0.z, n0.w, n1.x, n1.y, n1.z, n1.w};
        uint4 w; w.x = pk2(v[0] * rstd * nn[0] * gg[0], v[1] * rstd * nn[1] * gg[1]); w.y = pk2(v[2] * rstd * nn[2] * gg[2], v[3] * rstd * nn[3] * gg[3]);
        w.z = pk2(v[4] * rstd * nn[4] * gg[4], v[5] * rstd * nn[5] * gg[5]); w.w = pk2(v[6] * rstd * nn[6] * gg[6], v[7] * rstd * nn[7] * gg[7]);
        *(uint4*)(A3 + o) = w;
    }
}
__device__ __forceinline__ void ph_final(Frame& F) {
    for (int row = F.gw; row < LAT; row += F.NGW) { float* xr = F.out() + (size_t)row * D;
        float4 v[4]; float s = 0.f;
#pragma unroll
        for (int j = 0; j < 4; ++j) { v[j] = *(const float4*)(xr + j * 256 + F.lane * 4); s += (v[j].x * v[j].x + v[j].y * v[j].y) + (v[j].z * v[j].z + v[j].w * v[j].w); }
        const float rstd = rsqrtf(wave_sum(s) * (1.f / D) + EPS);
#pragma unroll
        for (int j = 0; j < 4; ++j) { const float4 g = *(const float4*)(F.final_norm() + j * 256 + F.lane * 4); *(float4*)(xr + j * 256 + F.lane * 4) = make_float4(v[j].x * rstd * g.x, v[j].y * rstd * g.y, v[j].z * rstd * g.z, v[j].w * rstd * g.w); }
    }
}

constexpr int NPHASE = 14;
#ifndef PROBE_DUP
#define PROBE_DUP -1
#endif
#ifndef OPT_P2
#define OPT_P2 1
#endif
#ifndef OPT_P4
#define OPT_P4 1
#endif
#ifndef OPT_P6
#define OPT_P6 1
#endif
#ifndef OPT_P7
#define OPT_P7 1
#endif
#ifndef OPT_P10
#define OPT_P10 1
#endif
#ifndef OPT_P5
#define OPT_P5 1
#endif
#ifndef OPT_P11
#define OPT_P11 1
#endif
#ifndef OPT_P3
#define OPT_P3 1
#endif
#ifndef OPT_P8
#define OPT_P8 1
#endif
#ifndef OPT_P12
#define OPT_P12 1
#endif
__global__ void __launch_bounds__(NTHR, 2) mk_fwd(Args args) {
    extern __shared__ __attribute__((aligned(16))) unsigned char lds_raw[];
    Frame F(args);
    F.lds = (LAS unsigned char*)lds_raw;
    F.tid = threadIdx.x; F.lane = F.tid & 63; F.wave = __builtin_amdgcn_readfirstlane(F.tid >> 6);
    F.gw = blockIdx.x * 8 + F.wave; F.NGW = gridDim.x * 8; F.gt = blockIdx.x * NTHR + F.tid; F.NGT = gridDim.x * NTHR;
    unsigned char* ws = args.ws;

    volatile LAS unsigned* MISC = (volatile LAS unsigned*)(F.lds + LDS_MISC);
    if (F.tid < 64) MISC[F.tid] = 0u;
    __syncthreads();
    XcdBarrier bar = xcd_barrier_post((unsigned*)(ws + OFF_CTL) + 1024, MISC + 8);
#define GRID_BAR() xcd_barrier(bar)
    const int lo = args.ph_lo, hi = args.ph_hi;
#define IN(k) (lo <= (k) && (k) < hi)
#define SEAM(k) do { if (IN(k) && IN((k) + 1)) GRID_BAR(); } while (0)

    if (IN(0)) { for (int rep_ = 0; rep_ < (PROBE_DUP == 0 ? 2 : 1); ++rep_) { if (rep_) GRID_BAR();
    { ph_mods(F); ph_small(F); __syncthreads(); ph_transposes(F); ph_weff(F); }
    } }
    SEAM(0);
    if (IN(1)) { for (int rep_ = 0; rep_ < (PROBE_DUP == 1 ? 2 : 1); ++rep_) { if (rep_) GRID_BAR();
    { ph_bias(F); ph_norm_mod(F); }
    } }
    SEAM(1);
    if (IN(2)) { for (int rep_ = 0; rep_ < (PROBE_DUP == 2 ? 2 : 1); ++rep_) { if (rep_) GRID_BAR();
    {
#if OPT_P2
        { pg8::Gemm g{F.A0(), F.Win0(), ROWS, EVN, 1024, 0}; pg8::StaticOrder S; S.init(ROWS, EVN, (int)gridDim.x, (int)blockIdx.x); mk::EpiIn0MK E{F.P0(), F.rope()};
          pg8::gemm_phase<mk::EpiIn0MK, pg8::StaticOrder, PG8_ALIGN, PG8_SP2>(F.lds, g, S, E); }
#else
        gemm_naive_phase(F, F.A0(), F.Win0(), EVN, 1024, 0, ROWS, EpiStore{F.P0(), EVN});
        GRID_BAR(); ph_rope(F);
#endif
        }
    } }
    SEAM(2);
    if (IN(3)) { for (int rep_ = 0; rep_ < (PROBE_DUP == 3 ? 2 : 1); ++rep_) { if (rep_) GRID_BAR();
    {
#if OPT_P3
        ph_attn_mk(F); ph_pool_d(F);
#else
        ph_attn_naive(F); ph_pool_d(F); GRID_BAR(); ph_readout0(F);
#endif
    }
    } }
    SEAM(3);
    if (IN(4)) { for (int rep_ = 0; rep_ < (PROBE_DUP == 4 ? 2 : 1); ++rep_) { if (rep_) GRID_BAR();
    {
#if OPT_P4
        { pg8::Gemm g{F.A1(), F.Wout0(), ROWS, 1024, 1024, 0}; pg8::StaticOrder S; S.init(ROWS, 1024, (int)gridDim.x, (int)blockIdx.x);
          mk::EpiResidMK E{F.x(), F.ctx(), F.out(), F.xc(), F.mods() + 2 * 1024, F.mods() + 4 * 1024, F.A0(), F.ssq()};
          pg8::gemm_phase<mk::EpiResidMK, pg8::StaticOrder, PG8_ALIGN, PG8_SP2>(F.lds, g, S, E); }
#else
        gemm_naive_phase(F, F.A1(), F.Wout0(), 1024, 1024, 0, ROWS, EpiResid{F.x(), F.ctx(), F.out(), F.xc(), F.mods() + 2 * 1024, F.mods() + 4 * 1024, F.A0()}); GRID_BAR(); ph_rowssq(F, ROWS);
#endif
    }
    } }
    SEAM(4);
    if (IN(5)) { for (int rep_ = 0; rep_ < (PROBE_DUP == 5 ? 2 : 1); ++rep_) { if (rep_) GRID_BAR();
    {
#if OPT_P5
        { pg8::Gemm g{F.A0() - 1024, F.Wup0(), ROWS, FF2, 1024, 1}; pg8::StaticOrder S; S.init2((ROWS + 247) / 248, FF2 / 256, (int)gridDim.x, (int)blockIdx.x);
          mk::EpiUpConvMK E{F.ssq(), F.bup(), F.conv_w(), F.conv_b(), F.G(), ROWS};
          pg8::gemm_phase<mk::EpiUpConvMK, pg8::StaticOrder, PG8_ALIGN, PG8_SP2>(F.lds, g, S, E); }
#else
        for (int c0 = 0; c0 < ROWS; c0 += 4608) { const int c1 = c0 + 4608, rb = c0 - 1, re = c1 + 1 > ROWS ? ROWS : c1 + 1;
            gemm_naive_phase(F, F.A0(), F.Wup0(), FF2, 1024, rb, re, EpiUp{F.UCH(), rb, F.ssq(), F.bup()}); GRID_BAR(); ph_convgate(F, 0, rb, c0, c1); if (c1 < ROWS) GRID_BAR(); }
#endif
    }
    } }
    SEAM(5);
    if (IN(6)) { for (int rep_ = 0; rep_ < (PROBE_DUP == 6 ? 2 : 1); ++rep_) { if (rep_) GRID_BAR();
    {
#if OPT_P6
        { pg8::Gemm g{F.G(), F.Wdn0(), ROWS, 1024, FF, 0}; pg8::StaticOrder S; S.init(ROWS, 1024, (int)gridDim.x, (int)blockIdx.x);
          mk::EpiResidMK E{F.out(), F.xc(), F.out(), F.xc(), F.mods() + 5 * 1024, F.mods() + 9 * 6144 + 1 * 1024, F.A0(), F.ssq()};
          pg8::gemm_phase<mk::EpiResidMK, pg8::StaticOrder, PG8_ALIGN, PG8_SP2>(F.lds, g, S, E); }
#else
        gemm_naive_phase(F, F.G(), F.Wdn0(), 1024, FF, 0, ROWS, EpiResid{F.out(), F.xc(), F.out(), F.xc(), F.mods() + 5 * 1024, F.mods() + 9 * 6144 + 1 * 1024, F.A0()}); GRID_BAR(); ph_rowssq(F, ROWS);
#endif
    }
    } }
    SEAM(6);
    if (IN(7)) { for (int rep_ = 0; rep_ < (PROBE_DUP == 7 ? 2 : 1); ++rep_) { if (rep_) GRID_BAR();
    {
#if OPT_P7
        { pg8::Gemm g{F.A0(), F.Win1(), ROWS, HGN, 1024, 0}; mk::OrderIn1 S; S.init((int)gridDim.x, (int)blockIdx.x);
          mk::EpiIn1MK E{F.ssq(), F.bin1(), F.misc() + 1024, F.Q1(), F.GG1(), F.V1(), F.LF1(), F.LB1()};
          pg8::gemm_phase<mk::EpiIn1MK, mk::OrderIn1, PG8_ALIGN, PG8_SP2>(F.lds, g, S, E); }
#else
        gemm_naive_phase(F, F.A0(), F.Win1(), HGN, 1024, 0, ROWS, EpiIn1{F.ssq(), F.bin1(), F.misc() + 1024, F.Q1(), F.GG1(), F.V1(), F.LF1(), F.LB1()});
#endif
    }
    } }
    SEAM(7);
    if (IN(8)) { for (int rep_ = 0; rep_ < (PROBE_DUP == 8 ? 2 : 1); ++rep_) { if (rep_) GRID_BAR();
    {
#if OPT_P8
        ph_scan_mk(F);
#else
        ph_scan_naive(F, 0); ph_scan_naive(F, 1);
#endif
    }
    } }
    SEAM(8);
    if (IN(9)) { for (int rep_ = 0; rep_ < (PROBE_DUP == 9 ? 2 : 1); ++rep_) { if (rep_) GRID_BAR();
    { ph_combine1(F); ph_transposes_l1ffn(F); }
    } }
    SEAM(9);
    if (IN(10)) { for (int rep_ = 0; rep_ < (PROBE_DUP == 10 ? 2 : 1); ++rep_) { if (rep_) GRID_BAR();
    {
        ph_bias_up1(F);
#if OPT_P10
        { pg8::Gemm g{F.A3(), F.Wout1(), LAT, 1024, 1024, 0}; pg8::StaticOrder S; S.init(LAT, 1024, (int)gridDim.x, (int)blockIdx.x);
          mk::EpiResidMK E{F.out(), F.xc(), F.out(), F.xc(), F.mods() + 9 * 6144 + 2 * 1024, F.mods() + 9 * 6144 + 4 * 1024, F.A0(), F.ssq()};
          pg8::gemm_phase<mk::EpiResidMK, pg8::StaticOrder, PG8_ALIGN, PG8_SP2>(F.lds, g, S, E); }
#else
        gemm_naive_phase(F, F.A3(), F.Wout1(), 1024, 1024, 0, LAT, EpiResid{F.out(), F.xc(), F.out(), F.xc(), F.mods() + 9 * 6144 + 2 * 1024, F.mods() + 9 * 6144 + 4 * 1024, F.A0()}); GRID_BAR(); ph_rowssq(F, LAT);
#endif
    }
    } }
    SEAM(10);
    if (IN(11)) { for (int rep_ = 0; rep_ < (PROBE_DUP == 11 ? 2 : 1); ++rep_) { if (rep_) GRID_BAR();
    {
#if OPT_P11
        { pg8::Gemm g{F.A0() - 1024, F.Wup1(), LAT, FF2, 1024, 1}; pg8::StaticOrder S; S.init2((LAT + 247) / 248, FF2 / 256, (int)gridDim.x, (int)blockIdx.x);
          mk::EpiUpConvMK E{F.ssq(), F.bup() + 9 * FF2, F.conv_w() + 3 * FF2, F.conv_b() + FF2, F.G(), LAT};
          pg8::gemm_phase<mk::EpiUpConvMK, pg8::StaticOrder, PG8_ALIGN, PG8_SP2>(F.lds, g, S, E); }
#else
        for (int c0 = 0; c0 < LAT; c0 += 4608) { const int c1 = c0 + 4608 > LAT ? LAT : c0 + 4608, rb = c0 - 1, re = c1 + 1;
            gemm_naive_phase(F, F.A0(), F.Wup1(), FF2, 1024, rb, re, EpiUp{F.UCH(), rb, F.ssq(), F.bup() + 9 * FF2}); GRID_BAR(); ph_convgate(F, 1, rb, c0, c1); if (c1 < LAT) GRID_BAR(); }
#endif
    }
    } }
    SEAM(11);
    if (IN(12)) { for (int rep_ = 0; rep_ < (PROBE_DUP == 12 ? 2 : 1); ++rep_) { if (rep_) GRID_BAR();
    {
#if OPT_P12
        { pg8::Gemm g{F.G(), F.Wdn1(), LAT, 1024, FF, 0}; pg8::StaticOrder S; S.init(LAT, 1024, (int)gridDim.x, (int)blockIdx.x);
          mk::EpiResidMK E{F.out(), F.xc(), F.out(), F.xc(), F.mods() + 9 * 6144 + 5 * 1024, nullptr, nullptr, nullptr};
          pg8::gemm_phase<mk::EpiResidMK, pg8::StaticOrder, PG8_ALIGN, PG8_SP2>(F.lds, g, S, E); }
#else
        gemm_naive_phase(F, F.G(), F.Wdn1(), 1024, FF, 0, LAT, EpiResid{F.out(), F.xc(), F.out(), F.xc(), F.mods() + 9 * 6144 + 5 * 1024, nullptr, nullptr});
#endif
    }
    } }
    SEAM(12);
    if (IN(13)) { for (int rep_ = 0; rep_ < (PROBE_DUP == 13 ? 2 : 1); ++rep_) { if (rep_) GRID_BAR();
    { ph_final(F); }
    } }
}

extern "C" void kernel_launch(void* const* d_in, const int* in_sizes, int n_in, void* d_out, int out_size, void* d_ws, size_t ws_size, hipStream_t st) {
    static int grid = 0;
    if (grid == 0) {
        if (n_in != 24 || ws_size < WS_END || out_size != LAT * D) { fprintf(stderr, "kernel_launch: unexpected shapes (n_in %d, ws %zu, out %d)\n", n_in, ws_size, out_size); grid = -1; return; }
        int dev = 0, cus = 0;
        if (hipGetDevice(&dev) != hipSuccess || hipDeviceGetAttribute(&cus, hipDeviceAttributeMultiprocessorCount, dev) != hipSuccess) { grid = -1; return; }
        if (hipFuncSetAttribute((const void*)mk_fwd, hipFuncAttributeMaxDynamicSharedMemorySize, LDS_BYTES) != hipSuccess) { fprintf(stderr, "kernel_launch: hipFuncSetAttribute failed\n"); grid = -1; return; }
        int per_cu = 0; (void)hipOccupancyMaxActiveBlocksPerMultiprocessor(&per_cu, (const void*)mk_fwd, NTHR, LDS_BYTES); (void)hipGetLastError();
        if (per_cu < 1) fprintf(stderr, "kernel_launch: occupancy query reports %d\n", per_cu);
        grid = cus;
    }
    if (grid < 0) return;
    (void)hipMemsetAsync((char*)d_ws + OFF_CTL, 0, CTL_ZERO_BYTES, st);
    Args a{};
    for (int i = 0; i < 24; ++i) a.in[i] = (const float*)d_in[i];
    a.out = (float*)d_out; a.ws = (unsigned char*)d_ws; a.ph_lo = 0; a.ph_hi = NPHASE;
    hipLaunchKernelGGL(mk_fwd, dim3(grid), dim3(NTHR), LDS_BYTES, st, a);
}
```
